# Optimizing an MI355X kernel written in HIP

```python
import math
import jax, jax.numpy as jnp
from jax import lax
import numpy as np

D_MODEL = 2048
BATCH = 2
SEQ = 8192
DEPTH = 1

N_META = 16
POOL_WIDTH = 1024
POOL_GROUPS = 4
POOL_WINDOWS = (2, 4, 8, 16)
POOL_GC = POOL_WIDTH // POOL_GROUPS
CONV_WIDTH = 1024
CONV_K = 3
N_BRANCH = 2
IN_COLS = POOL_WIDTH + 3 * CONV_WIDTH + N_BRANCH * D_MODEL
PEER_HEADS = 8
PEER_QDIM = 256
PEER_HALF = PEER_QDIM // 2
N_KEYS = 128
N_EXPERTS = N_KEYS * N_KEYS
PEER_TOPK = 16
PEER_BLOCK = 128
DN_ALPHA = (2.0 * DEPTH) ** 0.25
DN_BETA = (8.0 * DEPTH) ** -0.25
LN_EPS = 1e-5

kernel_name = "hybrid_pool_shortconv_peer_deepnorm_block"


def _layer_norm(x, g, b):
    xf = x.astype(jnp.float32)
    mu = jnp.mean(xf, axis=-1, keepdims=True)
    var = jnp.mean(jnp.square(xf - mu), axis=-1, keepdims=True)
    y = (xf - mu) * lax.rsqrt(var + LN_EPS) * g.astype(jnp.float32) + b.astype(jnp.float32)
    return y.astype(x.dtype)


def _causal_multiscale_pool(a):
    bsz, t_len, _ = a.shape
    af = a.astype(jnp.float32).reshape(bsz, t_len, POOL_GROUPS, POOL_GC)
    cs = jnp.cumsum(af, axis=1)
    pos = jnp.arange(t_len)
    outs = []
    for g, w in enumerate(POOL_WINDOWS):
        csg = cs[:, :, g]
        lag = jnp.pad(csg, ((0, 0), (w, 0), (0, 0)))[:, :t_len]
        cnt = jnp.minimum(pos + 1, w).astype(jnp.float32)[None, :, None]
        outs.append((csg - lag) / cnt - af[:, :, g])
    return jnp.stack(outs, axis=2).astype(a.dtype)


def _causal_depthwise_conv(z, w, b):
    y = lax.conv_general_dilated(
        z, w, window_strides=(1,), padding=[(CONV_K - 1, 0)],
        dimension_numbers=("NWC", "WIO", "NWC"), feature_group_count=z.shape[-1])
    return y + b


def _peer(xf, w_q, keys_1, keys_2, expert_u, expert_v):
    n = xf.shape[0]
    n_pad = (-n) % PEER_BLOCK
    xb_all = jnp.pad(xf, ((0, n_pad), (0, 0))).reshape(-1, PEER_BLOCK, D_MODEL)

    def block(xb):
        q = (xb @ w_q).reshape(PEER_BLOCK, PEER_HEADS, 2, PEER_HALF)
        s1 = jnp.einsum("thc,hnc->thn", q[:, :, 0], keys_1)
        s2 = jnp.einsum("thc,hnc->thn", q[:, :, 1], keys_2)
        v1, i1 = lax.top_k(s1, PEER_TOPK)
        v2, i2 = lax.top_k(s2, PEER_TOPK)
        n_cand = PEER_TOPK * PEER_TOPK
        cand_s = (v1[..., :, None] + v2[..., None, :]).reshape(PEER_BLOCK, PEER_HEADS, n_cand)
        cand_i = (i1[..., :, None] * N_KEYS + i2[..., None, :]).reshape(PEER_BLOCK, PEER_HEADS, n_cand)
        top_s, sel = lax.top_k(cand_s, PEER_TOPK)
        idx = jnp.take_along_axis(cand_i, sel, axis=-1).reshape(PEER_BLOCK, PEER_HEADS * PEER_TOPK)
        gate = jax.nn.softmax(top_s.astype(jnp.float32), axis=-1).reshape(PEER_BLOCK, PEER_HEADS * PEER_TOPK)
        u = expert_u[idx]
        act = jax.nn.gelu(jnp.einsum("td,tkd->tk", xb, u).astype(jnp.float32), approximate=False)
        coef = (gate * act).astype(xb.dtype)
        return jnp.einsum("tk,tkd->td", coef, expert_v[idx])

    return lax.map(block, xb_all).reshape(-1, D_MODEL)[:n]


def setup_inputs(seed: int = 0) -> dict:
    key = jax.random.key(seed)
    ks = jax.random.split(key, 24)
    f32 = jnp.float32
    L = DEPTH

    def nrm(k, shape, scale):
        return jax.random.normal(k, shape, f32) * scale

    return {
        "x": nrm(ks[0], (BATCH, SEQ, D_MODEL), 1.0),
        "meta_tokens": nrm(ks[1], (N_META, D_MODEL), 1.0),
        "ln_in_g": 1.0 + nrm(ks[2], (D_MODEL,), 0.02),
        "ln_in_b": nrm(ks[3], (D_MODEL,), 0.02),
        "w_in": nrm(ks[4], (L, D_MODEL, IN_COLS), D_MODEL ** -0.5),
        "pool_w": nrm(ks[5], (L, POOL_GROUPS, POOL_GC, POOL_GC), POOL_GC ** -0.5),
        "pool_scale": 1.0 + nrm(ks[6], (L, POOL_WIDTH), 0.02),
        "pool_proj": nrm(ks[7], (L, POOL_WIDTH, D_MODEL), POOL_WIDTH ** -0.5),
        "conv_w": nrm(ks[8], (L, CONV_K, 1, CONV_WIDTH), CONV_K ** -0.5),
        "conv_b": nrm(ks[9], (L, CONV_WIDTH), 0.02),
        "conv_proj": nrm(ks[10], (L, CONV_WIDTH, D_MODEL), CONV_WIDTH ** -0.5),
        "w_out": nrm(ks[11], (L, D_MODEL, D_MODEL), DN_BETA * D_MODEL ** -0.5),
        "ln1_g": 1.0 + nrm(ks[12], (L, D_MODEL), 0.02),
        "ln1_b": nrm(ks[13], (L, D_MODEL), 0.02),
        "peer_wq": nrm(ks[14], (L, D_MODEL, PEER_HEADS * PEER_QDIM), D_MODEL ** -0.5),
        "peer_keys_1": nrm(ks[15], (L, PEER_HEADS, N_KEYS, PEER_HALF), PEER_HALF ** -0.5),
        "peer_keys_2": nrm(ks[16], (L, PEER_HEADS, N_KEYS, PEER_HALF), PEER_HALF ** -0.5),
        "expert_u": nrm(ks[17], (L, N_EXPERTS, D_MODEL), D_MODEL ** -0.5),
        "expert_v": nrm(ks[18], (L, N_EXPERTS, D_MODEL), DN_BETA * PEER_HEADS ** -0.5),
        "ln2_g": 1.0 + nrm(ks[19], (L, D_MODEL), 0.02),
        "ln2_b": nrm(ks[20], (L, D_MODEL), 0.02),
    }


def reference(x, meta_tokens, ln_in_g, ln_in_b, w_in, pool_w, pool_scale, pool_proj,
              conv_w, conv_b, conv_proj, w_out, ln1_g, ln1_b, peer_wq, peer_keys_1,
              peer_keys_2, expert_u, expert_v, ln2_g, ln2_b):
    bsz = x.shape[0]
    meta = jnp.broadcast_to(meta_tokens.astype(x.dtype)[None], (bsz, N_META, D_MODEL))
    h = jnp.concatenate([meta, x], axis=1)
    h = _layer_norm(h, ln_in_g, ln_in_b)
    t_len = h.shape[1]
    c1 = POOL_WIDTH
    c2 = c1 + CONV_WIDTH
    c3 = c2 + CONV_WIDTH
    c4 = c3 + CONV_WIDTH

    for l in range(DEPTH):
        proj = h @ w_in[l]
        a = proj[..., :c1]
        zh, zb, zc = proj[..., c1:c2], proj[..., c2:c3], proj[..., c3:c4]
        gates = jax.nn.sigmoid(proj[..., c4:].astype(jnp.float32)).astype(h.dtype)
        gates = gates.reshape(bsz, t_len, N_BRANCH, D_MODEL)

        pooled = _causal_multiscale_pool(a)
        ya = jnp.einsum("btgc,gcd->btgd", pooled, pool_w[l]).reshape(bsz, t_len, POOL_WIDTH)
        ya = (ya * pool_scale[l]) @ pool_proj[l]

        yb = zb * _causal_depthwise_conv(zc * zh, conv_w[l], conv_b[l])
        yb = yb @ conv_proj[l]

        mixed = (gates[:, :, 0] * ya + gates[:, :, 1] * yb) @ w_out[l]
        h = _layer_norm(DN_ALPHA * h + mixed, ln1_g[l], ln1_b[l])

        y = _peer(h.reshape(-1, D_MODEL), peer_wq[l], peer_keys_1[l], peer_keys_2[l],
                  expert_u[l], expert_v[l]).reshape(bsz, t_len, D_MODEL)
        h = _layer_norm(DN_ALPHA * h + y, ln2_g[l], ln2_b[l])

    return h[:, N_META:]
```

```cpp
#include <hip/hip_runtime.h>
#include <hip/hip_cooperative_groups.h>
#include <cstdio>
#include <cstdint>
namespace cg = cooperative_groups;

#ifndef N_LAUNCH_MODE
#define N_LAUNCH_MODE 1
#endif
#ifndef USE_PG8
#define USE_PG8 1
#endif

#define LAS __attribute__((address_space(3)))
typedef unsigned short bf16_t;
typedef short bf16x8 __attribute__((ext_vector_type(8)));
typedef float f32x4 __attribute__((ext_vector_type(4)));
typedef float f32x16 __attribute__((ext_vector_type(16)));
typedef unsigned u32x4 __attribute__((ext_vector_type(4)));
typedef unsigned u32x2 __attribute__((ext_vector_type(2)));

constexpr int D = 2048, M = 16384, SEQ = 8192, NMETA = 16;
constexpr int NTH = 512, NWAVE = 8;
constexpr float ALPHA = 1.189207115002721f;
constexpr float LN_EPS = 1e-5f;
constexpr float STAT_FX = 16384.0f;
constexpr int LDS_BYTES = 8 * 20304 + 1024;

constexpr size_t MiB = 1024 * 1024;
constexpr size_t WS_CTL   = 0;
constexpr size_t WS_HM    = 64 * 1024;
constexpr size_t WS_PMETA = WS_HM + 64 * 1024;
constexpr size_t WS_KEYS  = WS_PMETA + 192 * 1024;
constexpr size_t WS_PW_T  = WS_KEYS + 512 * 1024;
constexpr size_t WS_WIN_T = 2 * MiB;
constexpr size_t WS_W2_T  = WS_WIN_T + 32 * MiB;
constexpr size_t WS_WO_T  = WS_W2_T + 8 * MiB;
constexpr size_t WS_WQ_T  = WS_WO_T + 8 * MiB;
constexpr size_t WS_EU    = WS_WQ_T + 8 * MiB;
constexpr size_t WS_EV    = WS_EU + 64 * MiB;
constexpr size_t WS_H0    = WS_EV + 64 * MiB;
constexpr size_t WS_PAZ   = WS_H0 + 64 * MiB;
constexpr size_t WS_POOLED= WS_PAZ + 128 * MiB;
constexpr size_t WS_A2    = WS_POOLED + 32 * MiB;
constexpr size_t WS_END   = WS_A2 + 64 * MiB;
constexpr size_t WS_CS = WS_CTL + 16384, WS_BW = WS_CTL + 24576;
constexpr size_t WS_STATS = WS_PW_T;
constexpr size_t WS_H0_8 = WS_EU + 20 * MiB;
constexpr size_t WS_WIN8 = WS_EV + 20 * MiB;
constexpr size_t EXP_SC_OFF = 16 * MiB;

__device__ __forceinline__ unsigned f2bf(float f) { unsigned u = __float_as_uint(f); return (u + 0x7fffu + ((u >> 16) & 1u)) >> 16; }
typedef float f32x2_ __attribute__((ext_vector_type(2)));
typedef __bf16 bf16x2_ __attribute__((ext_vector_type(2)));
__device__ __forceinline__ unsigned pk2(float lo, float hi) { const f32x2_ v = {lo, hi}; return __builtin_bit_cast(unsigned, __builtin_convertvector(v, bf16x2_)); }
__device__ __forceinline__ float bflo(unsigned u) { return __uint_as_float(u << 16); }
__device__ __forceinline__ float bfhi(unsigned u) { return __uint_as_float(u & 0xffff0000u); }
__device__ __forceinline__ float bf1(bf16_t b) { return __uint_as_float(((unsigned)b) << 16); }
__device__ __forceinline__ float wave_sum(float v) {
#pragma unroll
    for (int o = 1; o < 64; o <<= 1) v += __shfl_xor(v, o);
    return v;
}
__device__ __forceinline__ float i64f(long long v) { return __builtin_fmaf((float)(int)(v >> 32), 4294967296.0f, (float)(unsigned)v); }
__device__ __forceinline__ float sigmoidf_(float x) { return __builtin_amdgcn_rcpf(1.0f + __expf(-x)); }
__device__ __forceinline__ float gelu_erf(float x) { return 0.5f * x * (1.0f + erff(x * 0.70710678118654752f)); }
__device__ __forceinline__ unsigned ord_f32(float f) { unsigned u = __float_as_uint(f); return u ^ ((u >> 31) ? 0xffffffffu : 0x80000000u); }
__device__ __forceinline__ float unord_f32(unsigned u) { return __uint_as_float(u ^ ((u >> 31) ? 0x80000000u : 0xffffffffu)); }

struct Args {
    const float* in[21];
    float* out;
    unsigned char* ws;
    int ph_lo, ph_hi;
};

constexpr int NO_SPLIT = 1 << 30;
struct EpiGen {
    bf16_t* out; int ldo;
    bf16_t* out2; int split;
    const float* colscale;
    const bf16_t* mul; int ldm;
    const bf16_t* add; int lda_; float add_scale;
    const bf16_t* mid_num; const bf16_t* mid_den; int ld_mid;
    unsigned long long* stats_out;
    const long long* ln_stats; const float* ln_cs; const float* ln_bw;
    __device__ __forceinline__ void elem(int row, int col, float acc) const {
        if (col >= split) { out2[(size_t)row * ldo + (col - split)] = (bf16_t)f2bf(sigmoidf_(acc)); return; }
        float v = acc;
        if (colscale) v *= colscale[col];
        if (mul) v *= fmaxf(bf1(mul[(size_t)row * ldm + col]), 1e-30f);
        if (add) v += add_scale * bf1(add[(size_t)row * lda_ + col]);
        out[(size_t)row * ldo + col] = (bf16_t)f2bf(v);
    }
    __device__ __forceinline__ void mid8(int row, int col, f32x4& v0, f32x4& v1) const {
        const u32x4 gn = __builtin_nontemporal_load((const u32x4*)(mid_num + (size_t)row * ld_mid + col)), gd = *(const u32x4*)(mid_den + (size_t)row * ld_mid + col);
        v0[0] *= bflo(gn.x) * __builtin_amdgcn_rcpf(fmaxf(bflo(gd.x), 1e-30f)); v0[1] *= bfhi(gn.x) * __builtin_amdgcn_rcpf(fmaxf(bfhi(gd.x), 1e-30f));
        v0[2] *= bflo(gn.y) * __builtin_amdgcn_rcpf(fmaxf(bflo(gd.y), 1e-30f)); v0[3] *= bfhi(gn.y) * __builtin_amdgcn_rcpf(fmaxf(bfhi(gd.y), 1e-30f));
        v1[0] *= bflo(gn.z) * __builtin_amdgcn_rcpf(fmaxf(bflo(gd.z), 1e-30f)); v1[1] *= bfhi(gn.z) * __builtin_amdgcn_rcpf(fmaxf(bfhi(gd.z), 1e-30f));
        v1[2] *= bflo(gn.w) * __builtin_amdgcn_rcpf(fmaxf(bflo(gd.w), 1e-30f)); v1[3] *= bfhi(gn.w) * __builtin_amdgcn_rcpf(fmaxf(bfhi(gd.w), 1e-30f));
    }
    __device__ __forceinline__ void vec8(int row, int col, f32x4 v0, f32x4 v1, float& rs, float& rq) const {
        if (col >= split) {
            u32x4 w; w.x = pk2(sigmoidf_(v0[0]), sigmoidf_(v0[1])); w.y = pk2(sigmoidf_(v0[2]), sigmoidf_(v0[3]));
            w.z = pk2(sigmoidf_(v1[0]), sigmoidf_(v1[1])); w.w = pk2(sigmoidf_(v1[2]), sigmoidf_(v1[3]));
            __builtin_nontemporal_store(w, (u32x4*)(out2 + (size_t)row * ldo + (col - split))); return;
        }
        if (ln_stats) { const float sm = i64f(ln_stats[2 * row]) * (1.0f / STAT_FX), sq = i64f(ln_stats[2 * row + 1]) * (1.0f / STAT_FX);
            const float mean = sm * (1.0f / D), rstd = rsqrtf(fmaxf(sq * (1.0f / D) - mean * mean, 0.f) + LN_EPS);
            const f32x4 c0 = *(const f32x4*)(ln_cs + col), c1 = *(const f32x4*)(ln_cs + col + 4), b0 = *(const f32x4*)(ln_bw + col), b1 = *(const f32x4*)(ln_bw + col + 4);
            v0 = (v0 - mean * c0) * rstd + b0; v1 = (v1 - mean * c1) * rstd + b1; }
        if (colscale) { const f32x4 s0 = *(const f32x4*)(colscale + col), s1 = *(const f32x4*)(colscale + col + 4); v0 *= s0; v1 *= s1; }
        if (mul) { const u32x4 g = __builtin_nontemporal_load((const u32x4*)(mul + (size_t)row * ldm + col));
            v0[0] *= fmaxf(bflo(g.x), 1e-30f); v0[1] *= fmaxf(bfhi(g.x), 1e-30f); v0[2] *= fmaxf(bflo(g.y), 1e-30f); v0[3] *= fmaxf(bfhi(g.y), 1e-30f);
            v1[0] *= fmaxf(bflo(g.z), 1e-30f); v1[1] *= fmaxf(bfhi(g.z), 1e-30f); v1[2] *= fmaxf(bflo(g.w), 1e-30f); v1[3] *= fmaxf(bfhi(g.w), 1e-30f); }
        if (add) { const u32x4 g = __builtin_nontemporal_load((const u32x4*)(add + (size_t)row * lda_ + col));
            v0[0] += add_scale * bflo(g.x); v0[1] += add_scale * bfhi(g.x); v0[2] += add_scale * bflo(g.y); v0[3] += add_scale * bfhi(g.y);
            v1[0] += add_scale * bflo(g.z); v1[1] += add_scale * bfhi(g.z); v1[2] += add_scale * bflo(g.w); v1[3] += add_scale * bfhi(g.w); }
        u32x4 w; w.x = pk2(v0[0], v0[1]); w.y = pk2(v0[2], v0[3]); w.z = pk2(v1[0], v1[1]); w.w = pk2(v1[2], v1[3]);
        *(u32x4*)(out + (size_t)row * ldo + col) = w;
        if (stats_out) { const float r0 = bflo(w.x), r1 = bfhi(w.x), r2 = bflo(w.y), r3 = bfhi(w.y), r4 = bflo(w.z), r5 = bfhi(w.z), r6 = bflo(w.w), r7 = bfhi(w.w);
            rs += ((r0 + r1) + (r2 + r3)) + ((r4 + r5) + (r6 + r7)); rq += ((r0 * r0 + r1 * r1) + (r2 * r2 + r3 * r3)) + ((r4 * r4 + r5 * r5) + (r6 * r6 + r7 * r7)); }
    }
};

struct GemmDesc { const bf16_t* A; int lda; const bf16_t* Bt; int ldb; int Mr, Nc, K; int a_pn_cols; };

__device__ __forceinline__ void naive_gemm(LAS unsigned char* lds_, const GemmDesc g, const EpiGen& E) {
    LAS float* As = (LAS float*)lds_; LAS float* Bs = As + 64 * 33;
    const int tid = threadIdx.x, ty = tid >> 4, tx = tid & 15;
    const int ntn = g.Nc / 64, ntiles = (g.Mr / 64) * ntn;
    for (int tile = blockIdx.x; tile < ntiles; tile += gridDim.x) {
        const int tm = tile / ntn, tn = tile % ntn;
        const bf16_t* Ab = g.A + (size_t)(tm * 64) * g.lda + (size_t)((tn * 64) / 256) * g.a_pn_cols;
        const bf16_t* Bb = g.Bt + (size_t)(tn * 64) * g.ldb;
        float acc[2][4];
#pragma unroll
        for (int i = 0; i < 2; ++i)
#pragma unroll
            for (int j = 0; j < 4; ++j) acc[i][j] = 0.f;
        const int lr = tid >> 3, lc = (tid & 7) * 4;
        for (int k0 = 0; k0 < g.K; k0 += 32) {
            const u32x2 va = *(const u32x2*)(Ab + (size_t)lr * g.lda + k0 + lc);
            const u32x2 vb = *(const u32x2*)(Bb + (size_t)lr * g.ldb + k0 + lc);
            As[lr * 33 + lc + 0] = bflo(va.x); As[lr * 33 + lc + 1] = bfhi(va.x); As[lr * 33 + lc + 2] = bflo(va.y); As[lr * 33 + lc + 3] = bfhi(va.y);
            Bs[lr * 33 + lc + 0] = bflo(vb.x); Bs[lr * 33 + lc + 1] = bfhi(vb.x); Bs[lr * 33 + lc + 2] = bflo(vb.y); Bs[lr * 33 + lc + 3] = bfhi(vb.y);
            __syncthreads();
#pragma unroll 8
            for (int k = 0; k < 32; ++k) {
                const float a0 = As[ty * 33 + k], a1 = As[(ty + 32) * 33 + k];
                const float b0 = Bs[tx * 33 + k], b1 = Bs[(tx + 16) * 33 + k], b2 = Bs[(tx + 32) * 33 + k], b3 = Bs[(tx + 48) * 33 + k];
                acc[0][0] += a0 * b0; acc[0][1] += a0 * b1; acc[0][2] += a0 * b2; acc[0][3] += a0 * b3;
                acc[1][0] += a1 * b0; acc[1][1] += a1 * b1; acc[1][2] += a1 * b2; acc[1][3] += a1 * b3;
            }
            __syncthreads();
        }
#pragma unroll
        for (int i = 0; i < 2; ++i)
#pragma unroll
            for (int j = 0; j < 4; ++j) E.elem(tm * 64 + ty + 32 * i, tn * 64 + tx + 16 * j, acc[i][j]);
    }
}

namespace pg8 {
constexpr int BM = 256, BK = 64, HALF = 128, HTB = HALF * BK * 2, STAGE_BYTES = 8 * HTB, NXCD = 8, WGM = 4;
__device__ __forceinline__ int lds_byte(int r, int c) { const int st = (r >> 4) * 2 + (c >> 5), rr = r & 15, cc = c & 31, ob = rr * 64 + cc * 2; return st * 1024 + (ob ^ (((ob >> 9) & 1) << 5)); }
__device__ __forceinline__ void stage_rc(int b, int& R, int& C) { const int st = b / 1024, sb = b % 1024, swz = sb ^ (((sb >> 9) & 1) << 5); R = (st >> 1) * 16 + swz / 64; C = (st & 1) * 32 + (swz % 64) / 2; }
__device__ __forceinline__ int perm32(int rho) { const int n = rho >> 4, i = rho & 15; return 8 * (i >> 2) + 4 * n + (i & 3); }
struct Unit { int pm, pn; };
struct StaticOrder {
    int nM, nN, nwg, G, c;
    __device__ void init(int Mr, int Nc, int G_, int c_) { nM = Mr / BM; nN = Nc / BM; nwg = nM * nN; G = G_; c = c_; }
    __device__ bool next(int i, Unit& u) const {
        const long L = (long)i * G + c; if (L >= nwg) return false;
        int wgid = (int)L; { const int q = nwg / NXCD, r = nwg % NXCD, xcd = wgid % NXCD, off = wgid / NXCD; wgid = (xcd < r ? xcd * (q + 1) : r * (q + 1) + (xcd - r) * q) + off; }
        const int nig = WGM * nN, gid = wgid / nig, fm = gid * WGM, gsz = (nM - fm) < WGM ? (nM - fm) : WGM;
        u.pm = fm + ((wgid % nig) % gsz); u.pn = (wgid % nig) / gsz; return true;
    }
};
__device__ __forceinline__ void epilogue(const EpiGen& E, const f32x4 (&acc)[2][2][4][2], const Unit& u, int wr, int wc, int fr, int fq) {
    const int row0 = u.pm * BM + wr * 64 + fr, col0 = u.pn * BM + wc * 32 + 8 * fq;
#pragma unroll
    for (int ai = 0; ai < 2; ++ai)
#pragma unroll
        for (int m = 0; m < 4; ++m) {
            float rs = 0.f, rq = 0.f; const int row = row0 + ai * HALF + m * 16;
#pragma unroll
            for (int bj = 0; bj < 2; ++bj) E.vec8(row, col0 + bj * HALF, acc[ai][bj][m][0], acc[ai][bj][m][1], rs, rq);
            if (E.stats_out) {
                rs += __shfl_xor(rs, 16); rs += __shfl_xor(rs, 32); rq += __shfl_xor(rq, 16); rq += __shfl_xor(rq, 32);
                if (fq == 0) { atomicAdd(E.stats_out + 2 * row, (unsigned long long)(long long)__float2int_rn(rs * STAT_FX)); atomicAdd(E.stats_out + 2 * row + 1, (unsigned long long)(long long)__float2int_rn(rq * STAT_FX)); }
            }
        }
}
typedef int v8i __attribute__((ext_vector_type(8)));
typedef int v4i __attribute__((ext_vector_type(4)));
constexpr float FP8_W_UNSCALE = 0.015625f;
__device__ __forceinline__ v8i cat8(bf16x8 lo, bf16x8 hi) { const v4i a = __builtin_bit_cast(v4i, lo), b = __builtin_bit_cast(v4i, hi); v8i r; r[0] = a[0]; r[1] = a[1]; r[2] = a[2]; r[3] = a[3]; r[4] = b[0]; r[5] = b[1]; r[6] = b[2]; r[7] = b[3]; return r; }
__device__ __forceinline__ void mid_hook(const EpiGen& E, f32x4 (&acc)[2][2][4][2], const Unit& u, int wr, int wc, int fr_in, int fq_in) {
    int fr = fr_in, fq = fq_in;
    asm volatile("" : "+v"(fr), "+v"(fq));
    const int row0 = u.pm * BM + wr * 64 + fr, col0 = u.pn * BM + wc * 32 + 8 * fq;
#pragma unroll
    for (int ai = 0; ai < 2; ++ai)
#pragma unroll
        for (int m = 0; m < 4; ++m) {
#pragma unroll
            for (int bj = 0; bj < 2; ++bj) E.mid8(row0 + ai * HALF + m * 16, col0 + bj * HALF, acc[ai][bj][m][0], acc[ai][bj][m][1]);
            asm volatile("" ::: "memory"); }
}
template <bool FP8> __device__ __forceinline__ void gemm_phase(LAS unsigned char* lds, const GemmDesc g, const EpiGen& E) {
    const int tid = threadIdx.x, wid = __builtin_amdgcn_readfirstlane(tid >> 6), lane = tid & 63, wr = wid >> 2, wc = wid & 3, fr = lane & 15, fq = lane >> 4;
    const int K = g.K, nt = K / BK;
    StaticOrder S; S.init(g.Mr, g.Nc, (int)gridDim.x, (int)blockIdx.x);
    unsigned voffA[2], voffB[2];
#pragma unroll
    for (int i = 0; i < 2; ++i) { int R, C; stage_rc(tid * 16 + i * 8192, R, C); const int Rb = (R & ~31) + perm32(R & 31);
        voffA[i] = (unsigned)(R * g.lda + C) * 2u; voffB[i] = (unsigned)(Rb * g.ldb + C) * 2u; }
    const __amdgpu_buffer_rsrc_t rA = __builtin_amdgcn_make_buffer_rsrc((void*)g.A, 0, 0x7FFFFFFF, 0x00020000), rB = __builtin_amdgcn_make_buffer_rsrc((void*)g.Bt, 0, 0x7FFFFFFF, 0x00020000);
    const unsigned kstep = (unsigned)(BK * 2);
    const unsigned hstepA = (unsigned)HALF * g.lda * 2, hstepB = (unsigned)HALF * g.ldb * 2;
    const unsigned tstepA = 2 * hstepA, tstepB = 2 * hstepB;
    const unsigned pnA = (unsigned)g.a_pn_cols * 2;
    const unsigned ldsw = (unsigned)wid * 1024u;
    const int aoff = lds_byte(wr * 64 + fr, fq * 8), boff = lds_byte(wc * 32 + fr, fq * 8);
#define PG8_SA(b, h) (((b) * 2 + (h)) * HTB)
#define PG8_SB(b, h) ((4 + (b) * 2 + (h)) * HTB)
#define PG8_STAGE(bufoff, rs, soff, voff) do { _Pragma("unroll") for (int _i = 0; _i < 2; ++_i) \
        __builtin_amdgcn_raw_ptr_buffer_load_lds(rs, (LAS unsigned*)(lds + (bufoff) + ldsw + _i * 8192), 16, (int)(voff)[_i], (int)(soff), 0, 0); } while (0)
#define PG8_LDA(dst, b, h) do { _Pragma("unroll") for (int m = 0; m < 4; ++m) _Pragma("unroll") for (int k = 0; k < 2; ++k) dst[m][k] = *(const LAS bf16x8*)(lds + PG8_SA(b, h) + aoff + m * 2048 + k * 1024); } while (0)
#define PG8_LDB(dst, b, h) do { _Pragma("unroll") for (int n = 0; n < 2; ++n) _Pragma("unroll") for (int k = 0; k < 2; ++k) dst[n][k] = *(const LAS bf16x8*)(lds + PG8_SB(b, h) + boff + n * 2048 + k * 1024); } while (0)
#define PG8_MMA(ai, bj, At, Bt) do { __builtin_amdgcn_s_setprio(1); _Pragma("unroll") for (int m = 0; m < 4; ++m) _Pragma("unroll") for (int n = 0; n < 2; ++n) { \
        if constexpr (FP8) { acc[ai][bj][m][n] = __builtin_amdgcn_mfma_scale_f32_16x16x128_f8f6f4(cat8(Bt[n][0], Bt[n][1]), cat8(At[m][0], At[m][1]), acc[ai][bj][m][n], 0, 0, 0, 0, 0, 0); } \
        else { _Pragma("unroll") for (int k = 0; k < 2; ++k) acc[ai][bj][m][n] = __builtin_amdgcn_mfma_f32_16x16x32_bf16(Bt[n][k], At[m][k], acc[ai][bj][m][n], 0, 0, 0); } } \
        __builtin_amdgcn_s_setprio(0); } while (0)
#define PG8_WAIT_V(n) asm volatile("s_waitcnt vmcnt(" #n ")" ::: "memory")
#define PG8_WAIT_L(n) asm volatile("s_waitcnt lgkmcnt(" #n ")" ::: "memory")
#define PG8_BAR __builtin_amdgcn_s_barrier()
#define PG8_SCHED __builtin_amdgcn_sched_barrier(0)
    Unit cur, nxt; int ui = 0;
    if (!S.next(0, cur)) return;
    f32x4 acc[2][2][4][2];
#pragma unroll
    for (int a = 0; a < 2; ++a)
#pragma unroll
        for (int b = 0; b < 2; ++b)
#pragma unroll
            for (int m = 0; m < 4; ++m)
#pragma unroll
                for (int n = 0; n < 2; ++n) acc[a][b][m][n] = (f32x4){0.f, 0.f, 0.f, 0.f};
    bf16x8 At[4][2], B0[2][2], B1[2][2];
    unsigned cA = (unsigned)cur.pm * tstepA + (unsigned)cur.pn * pnA, cB = (unsigned)cur.pn * tstepB;
    PG8_STAGE(PG8_SB(0, 0), rB, cB, voffB); PG8_STAGE(PG8_SA(0, 0), rA, cA, voffA); PG8_STAGE(PG8_SB(0, 1), rB, cB + hstepB, voffB); PG8_STAGE(PG8_SA(0, 1), rA, cA + hstepA, voffA);
    if (wr == 1) PG8_BAR;
    PG8_WAIT_V(4); PG8_BAR;
    PG8_STAGE(PG8_SB(1, 0), rB, cB + kstep, voffB); PG8_STAGE(PG8_SA(1, 0), rA, cA + kstep, voffA); PG8_STAGE(PG8_SB(1, 1), rB, cB + hstepB + kstep, voffB);
    PG8_WAIT_V(6); PG8_BAR;
    for (;;) {
        const bool has_next = S.next(ui + 1, nxt);
        const unsigned nA = has_next ? (unsigned)nxt.pm * tstepA + (unsigned)nxt.pn * pnA : cA, nB = has_next ? (unsigned)nxt.pn * tstepB : cB;
        for (int t = 0; t < nt; t += 2) {
            const bool last = (t == nt - 2);
            const unsigned a1 = cA + (unsigned)(t + 1) * kstep;
            const unsigned a2 = last ? nA : cA + (unsigned)(t + 2) * kstep, b2 = last ? nB : cB + (unsigned)(t + 2) * kstep;
            const unsigned a3 = a2 + kstep, b3 = b2 + kstep;
            if (E.mid_num != nullptr && t == (nt >> 1)) mid_hook(E, acc, cur, wr, wc, fr, fq);
            PG8_LDB(B0, 0, 0); PG8_SCHED; PG8_LDA(At, 0, 0); PG8_STAGE(PG8_SA(1, 1), rA, a1 + hstepA, voffA);
            PG8_WAIT_L(8); PG8_BAR; PG8_WAIT_L(0); PG8_MMA(0, 0, At, B0); PG8_BAR; PG8_SCHED;
            PG8_LDB(B1, 0, 1); PG8_STAGE(PG8_SB(0, 0), rB, b2, voffB);
            PG8_BAR; PG8_WAIT_L(0); PG8_MMA(0, 1, At, B1); PG8_BAR;
            PG8_LDA(At, 0, 1); PG8_STAGE(PG8_SA(0, 0), rA, a2, voffA);
            PG8_BAR; PG8_WAIT_L(0); PG8_MMA(1, 0, At, B0); PG8_BAR; PG8_SCHED;
            PG8_STAGE(PG8_SB(0, 1), rB, b2 + hstepB, voffB);
            PG8_WAIT_V(6); PG8_BAR; PG8_MMA(1, 1, At, B1); PG8_BAR;
            PG8_LDB(B0, 1, 0); PG8_SCHED; PG8_LDA(At, 1, 0); PG8_STAGE(PG8_SA(0, 1), rA, a2 + hstepA, voffA);
            PG8_WAIT_L(8); PG8_BAR; PG8_WAIT_L(0); PG8_MMA(0, 0, At, B0); PG8_BAR; PG8_SCHED;
            PG8_LDB(B1, 1, 1); PG8_STAGE(PG8_SB(1, 0), rB, b3, voffB);
            PG8_BAR; PG8_WAIT_L(0); PG8_MMA(0, 1, At, B1); PG8_BAR;
            PG8_LDA(At, 1, 1); PG8_STAGE(PG8_SA(1, 0), rA, a3, voffA);
            PG8_BAR; PG8_WAIT_L(0); PG8_MMA(1, 0, At, B0); PG8_BAR; PG8_SCHED;
            PG8_STAGE(PG8_SB(1, 1), rB, b3 + hstepB, voffB);
            PG8_WAIT_V(6); PG8_BAR; PG8_MMA(1, 1, At, B1); PG8_BAR;
        }
        if constexpr (FP8) {
#pragma unroll
            for (int a = 0; a < 2; ++a)
#pragma unroll
                for (int b = 0; b < 2; ++b)
#pragma unroll
                    for (int m = 0; m < 4; ++m)
#pragma unroll
                        for (int n = 0; n < 2; ++n) acc[a][b][m][n] *= FP8_W_UNSCALE; }
        epilogue(E, acc, cur, wr, wc, fr, fq);
        if (!has_next) break;
#pragma unroll
        for (int a = 0; a < 2; ++a)
#pragma unroll
            for (int b = 0; b < 2; ++b)
#pragma unroll
                for (int m = 0; m < 4; ++m)
#pragma unroll
                    for (int n = 0; n < 2; ++n) acc[a][b][m][n] = (f32x4){0.f, 0.f, 0.f, 0.f};
        cur = nxt; cA = nA; cB = nB; ++ui;
    }
    PG8_WAIT_V(0);
    if (wr == 0) PG8_BAR;
    PG8_BAR;
#undef PG8_SA
#undef PG8_SB
#undef PG8_STAGE
#undef PG8_LDA
#undef PG8_LDB
#undef PG8_MMA
#undef PG8_WAIT_V
#undef PG8_WAIT_L
#undef PG8_BAR
#undef PG8_SCHED
}
}

__device__ __forceinline__ void run_gemm(LAS unsigned char* lds, const GemmDesc& g, const EpiGen& E) {
#if USE_PG8
    pg8::gemm_phase<false>(lds, g, E);
#else
    naive_gemm(lds, g, E);
    __syncthreads();
#endif
}

__device__ __forceinline__ void ln_row_f32_to_bf16(const float* xrow, const float* g, const float* b, bf16_t* orow, int lane) {
    const f32x4* xr = (const f32x4*)xrow + lane;
    f32x4 v[8]; float s = 0.f;
#pragma unroll
    for (int j = 0; j < 8; ++j) { v[j] = xr[64 * j]; s += (v[j][0] + v[j][1]) + (v[j][2] + v[j][3]); }
    const float mean = wave_sum(s) * (1.f / D); float s2 = 0.f;
#pragma unroll
    for (int j = 0; j < 8; ++j) { v[j] = v[j] - mean; s2 += (v[j][0] * v[j][0] + v[j][1] * v[j][1]) + (v[j][2] * v[j][2] + v[j][3] * v[j][3]); }
    const float rstd = rsqrtf(wave_sum(s2) * (1.f / D) + LN_EPS);
    u32x2* o8 = (u32x2*)orow + lane;
#pragma unroll
    for (int j = 0; j < 8; ++j) { const f32x4 gg = ((const f32x4*)g)[lane + 64 * j], bb = ((const f32x4*)b)[lane + 64 * j];
        const f32x4 y = v[j] * rstd * gg + bb; u32x2 w; w.x = pk2(y[0], y[1]); w.y = pk2(y[2], y[3]); o8[64 * j] = w; }
}
__device__ __forceinline__ void transpose_item(const float* W, int N, bf16_t* WT, int ldt, int koff, LAS float* scr, int item, int lane, const float* kscale = nullptr) {
    const int nblk = N / 32, kb = item / nblk, nb = item % nblk, k0 = 64 * kb, n0 = 32 * nb;
    float v[32];
#pragma unroll
    for (int i = 0; i < 32; ++i) { const int kk = 2 * i + (lane >> 5); v[i] = __builtin_nontemporal_load(W + (size_t)(k0 + kk) * N + n0 + (lane & 31)); }
#pragma unroll
    for (int i = 0; i < 32; ++i) { const int kk = 2 * i + (lane >> 5); const float ks = kscale ? kscale[k0 + kk] : 1.0f; scr[kk * 33 + (lane & 31)] = v[i] * ks; }
    asm volatile("s_waitcnt lgkmcnt(0)" ::: "memory");
    const int c = lane & 7;
#pragma unroll
    for (int j = 0; j < 4; ++j) { const int n = (lane >> 3) + 8 * j; const LAS float* s = scr + (8 * c) * 33 + n;
        u32x4 o; o.x = pk2(s[0 * 33], s[1 * 33]); o.y = pk2(s[2 * 33], s[3 * 33]); o.z = pk2(s[4 * 33], s[5 * 33]); o.w = pk2(s[6 * 33], s[7 * 33]);
        *(u32x4*)(WT + (size_t)(n0 + n) * ldt + koff + k0 + 8 * c) = o; }
    asm volatile("s_waitcnt lgkmcnt(0)" ::: "memory");
}
__device__ __forceinline__ void transpose_item_fp8(const float* W, int N, unsigned char* WT8, int n_base, float scale, LAS float* scr, int item, int lane) {
    const int nblk = N / 32, kb = item / nblk, nb = item % nblk, k0 = 64 * kb, n0 = 32 * nb;
    float v[32];
#pragma unroll
    for (int i = 0; i < 32; ++i) { const int kk = 2 * i + (lane >> 5); v[i] = __builtin_nontemporal_load(W + (size_t)(k0 + kk) * N + n0 + (lane & 31)); }
#pragma unroll
    for (int i = 0; i < 32; ++i) { const int kk = 2 * i + (lane >> 5); scr[kk * 33 + (lane & 31)] = v[i] * scale; }
    asm volatile("s_waitcnt lgkmcnt(0)" ::: "memory");
    const int c = lane & 7;
#pragma unroll
    for (int j = 0; j < 4; ++j) { const int n = (lane >> 3) + 8 * j; const LAS float* s = scr + (8 * c) * 33 + n;
        int p0 = 0, p1 = 0;
        p0 = __builtin_amdgcn_cvt_pk_fp8_f32(s[0 * 33], s[1 * 33], p0, false); p0 = __builtin_amdgcn_cvt_pk_fp8_f32(s[2 * 33], s[3 * 33], p0, true);
        p1 = __builtin_amdgcn_cvt_pk_fp8_f32(s[4 * 33], s[5 * 33], p1, false); p1 = __builtin_amdgcn_cvt_pk_fp8_f32(s[6 * 33], s[7 * 33], p1, true);
        u32x2 o; o.x = (unsigned)p0; o.y = (unsigned)p1;
        *(u32x2*)(WT8 + (size_t)(n0 - n_base + n) * 2048 + k0 + 8 * c) = o; }
    asm volatile("s_waitcnt lgkmcnt(0)" ::: "memory");
}
__device__ __forceinline__ void cvt_flat(const float* src, bf16_t* dst, size_t n8, size_t gt, size_t ngt) {
    for (size_t i = gt; i < n8; i += ngt) { const f32x4 a = ((const f32x4*)src)[2 * i], b = ((const f32x4*)src)[2 * i + 1];
        u32x4 o; o.x = pk2(a[0], a[1]); o.y = pk2(a[2], a[3]); o.z = pk2(b[0], b[1]); o.w = pk2(b[2], b[3]); ((u32x4*)dst)[i] = o; }
}

__device__ __forceinline__ void ln_2rows(const float* xa, bf16_t* oa, unsigned* oa8, const float* xb, bf16_t* ob, unsigned* ob8, const float* g, const float* b, int lane) {
    const f32x4* pa = (const f32x4*)xa + lane; const f32x4* pb = (const f32x4*)xb + lane;
    f32x4 va[8], vb[8];
#pragma unroll
    for (int j = 0; j < 8; ++j) va[j] = __builtin_nontemporal_load(pa + 64 * j);
#pragma unroll
    for (int j = 0; j < 8; ++j) vb[j] = __builtin_nontemporal_load(pb + 64 * j);
    float sa = 0.f, sb = 0.f;
#pragma unroll
    for (int j = 0; j < 8; ++j) { sa += (va[j][0] + va[j][1]) + (va[j][2] + va[j][3]); sb += (vb[j][0] + vb[j][1]) + (vb[j][2] + vb[j][3]); }
#pragma unroll
    for (int o = 1; o < 64; o <<= 1) { sa += __shfl_xor(sa, o); sb += __shfl_xor(sb, o); }
    const float ma = sa * (1.f / D), mb = sb * (1.f / D); float qa = 0.f, qb = 0.f;
#pragma unroll
    for (int j = 0; j < 8; ++j) { va[j] = va[j] - ma; vb[j] = vb[j] - mb;
        qa += (va[j][0] * va[j][0] + va[j][1] * va[j][1]) + (va[j][2] * va[j][2] + va[j][3] * va[j][3]); qb += (vb[j][0] * vb[j][0] + vb[j][1] * vb[j][1]) + (vb[j][2] * vb[j][2] + vb[j][3] * vb[j][3]); }
#pragma unroll
    for (int o = 1; o < 64; o <<= 1) { qa += __shfl_xor(qa, o); qb += __shfl_xor(qb, o); }
    const float ra = rsqrtf(qa * (1.f / D) + LN_EPS), rb = rsqrtf(qb * (1.f / D) + LN_EPS);
    u32x2* o8a = (u32x2*)oa + lane; u32x2* o8b = (u32x2*)ob + lane;
#pragma unroll
    for (int j = 0; j < 8; ++j) { const f32x4 gg = ((const f32x4*)g)[lane + 64 * j], bb = ((const f32x4*)b)[lane + 64 * j];
        const f32x4 ya = va[j] * ra * gg + bb, yb = vb[j] * rb * gg + bb; u32x2 w; w.x = pk2(ya[0], ya[1]); w.y = pk2(ya[2], ya[3]); o8a[64 * j] = w; w.x = pk2(yb[0], yb[1]); w.y = pk2(yb[2], yb[3]); o8b[64 * j] = w;
        if (oa8) { int p = 0; p = __builtin_amdgcn_cvt_pk_fp8_f32(ya[0], ya[1], p, false); p = __builtin_amdgcn_cvt_pk_fp8_f32(ya[2], ya[3], p, true); oa8[lane + 64 * j] = (unsigned)p; }
        if (ob8) { int p = 0; p = __builtin_amdgcn_cvt_pk_fp8_f32(yb[0], yb[1], p, false); p = __builtin_amdgcn_cvt_pk_fp8_f32(yb[2], yb[3], p, true); ob8[lane + 64 * j] = (unsigned)p; } }
}
__device__ __forceinline__ void fp4_pack_row(const f32x4 (&v)[8], unsigned* drow, unsigned char* sc_out, int sidx, int lane) {
    float am = 0.f;
#pragma unroll
    for (int m = 0; m < 8; ++m) am = fmaxf(fmaxf(am, fmaxf(fabsf(v[m][0]), fabsf(v[m][1]))), fmaxf(fabsf(v[m][2]), fabsf(v[m][3])));
    unsigned sb = (__float_as_uint(am * (1.0f / 6.0f)) + 0x7FFFFFu) & 0x7F800000u;
    sb = sb < (40u << 23) ? (40u << 23) : sb;
    const float scale = __uint_as_float(sb);
    u32x4 w;
#pragma unroll
    for (int d = 0; d < 4; ++d) { unsigned x = 0;
        x = __builtin_amdgcn_cvt_scalef32_pk_fp4_f32(x, v[2 * d][0], v[2 * d][1], scale, 0); x = __builtin_amdgcn_cvt_scalef32_pk_fp4_f32(x, v[2 * d][2], v[2 * d][3], scale, 1);
        x = __builtin_amdgcn_cvt_scalef32_pk_fp4_f32(x, v[2 * d + 1][0], v[2 * d + 1][1], scale, 2); x = __builtin_amdgcn_cvt_scalef32_pk_fp4_f32(x, v[2 * d + 1][2], v[2 * d + 1][3], scale, 3);
        w[d] = x; }
    __builtin_nontemporal_store(w, (u32x4*)drow + lane);
    sc_out[sidx] = (unsigned char)(sb >> 23);
}
__device__ __forceinline__ void transpose_item_wq(const float* W, bf16_t* WT, LAS float* scr, int item, int lane, const float* g1, const float* b1, float* part_cs, float* part_bw) {
    const int kb = item >> 6, nb = item & 63, k0 = 64 * kb, n0 = 32 * nb;
    float v[32];
#pragma unroll
    for (int i = 0; i < 32; ++i) { const int kk = 2 * i + (lane >> 5); v[i] = __builtin_nontemporal_load(W + (size_t)(k0 + kk) * 2048 + n0 + (lane & 31)); }
    float cs = 0.f, bw = 0.f;
#pragma unroll
    for (int i = 0; i < 32; ++i) { const int kk = 2 * i + (lane >> 5); const float sv = v[i] * g1[k0 + kk]; scr[kk * 33 + (lane & 31)] = sv; cs += bflo(f2bf(sv)); bw += v[i] * b1[k0 + kk]; }
    cs += __shfl_xor(cs, 32); bw += __shfl_xor(bw, 32);
    if (lane < 32) { part_cs[(size_t)kb * 2048 + n0 + lane] = cs; part_bw[(size_t)kb * 2048 + n0 + lane] = bw; }
    asm volatile("s_waitcnt lgkmcnt(0)" ::: "memory");
    const int c = lane & 7;
#pragma unroll
    for (int j = 0; j < 4; ++j) { const int n = (lane >> 3) + 8 * j; const LAS float* s = scr + (8 * c) * 33 + n;
        u32x4 o; o.x = pk2(s[0 * 33], s[1 * 33]); o.y = pk2(s[2 * 33], s[3 * 33]); o.z = pk2(s[4 * 33], s[5 * 33]); o.w = pk2(s[6 * 33], s[7 * 33]);
        *(u32x4*)(WT + (size_t)(n0 + n) * 2048 + k0 + 8 * c) = o; }
    asm volatile("s_waitcnt lgkmcnt(0)" ::: "memory");
}

__device__ __forceinline__ void phase0(const Args& a, LAS unsigned char* lds) {
    const int tid = threadIdx.x, lane = tid & 63, wave = tid >> 6;
    const int gw = blockIdx.x * NWAVE + wave, NGW = gridDim.x * NWAVE;
    unsigned char* ws = a.ws;
    LAS float* scr = (LAS float*)(lds + wave * 16384);
    for (int t = gw; t < 2048 && (gw & 1) == 0; t += NGW) {
        const int cin0 = (t >> 3) * 4, gI = cin0 >> 8, d0 = (t & 7) * 256 + lane; const float* pw = a.in[5] + (size_t)cin0 * 256; const float* psc = a.in[6] + gI * 256; const float* pp = a.in[7] + (size_t)(gI * 256) * 2048 + d0;
        float acc[4][4];
#pragma unroll
        for (int i = 0; i < 4; ++i)
#pragma unroll
            for (int j = 0; j < 4; ++j) acc[i][j] = 0.f;
        for (int c0 = 0; c0 < 256; c0 += 8) {
            float p[8][4];
#pragma unroll
            for (int cc = 0; cc < 8; ++cc)
#pragma unroll
                for (int j = 0; j < 4; ++j) p[cc][j] = pp[(size_t)(c0 + cc) * 2048 + 64 * j];
#pragma unroll
            for (int cc = 0; cc < 8; ++cc) {
                const int c = c0 + cc; const float sc = psc[c]; const float w0 = pw[c] * sc, w1 = pw[256 + c] * sc, w2 = pw[512 + c] * sc, w3 = pw[768 + c] * sc;
#pragma unroll
                for (int j = 0; j < 4; ++j) { acc[0][j] += w0 * p[cc][j]; acc[1][j] += w1 * p[cc][j]; acc[2][j] += w2 * p[cc][j]; acc[3][j] += w3 * p[cc][j]; }
            }
        }
        bf16_t* W2 = (bf16_t*)(ws + WS_W2_T);
#pragma unroll
        for (int j = 0; j < 4; ++j) { u32x2 o; o.x = pk2(acc[0][j], acc[1][j]); o.y = pk2(acc[2][j], acc[3][j]); *(u32x2*)(W2 + (size_t)(d0 + 64 * j) * 2048 + cin0) = o; }
    }
    for (int r = gw; r < 2 * 16384; r += 2 * NGW) {
        const int rb_ = (r + NGW < 2 * 16384) ? r + NGW : r;
        const int tba = r >> 14, ea = r & 16383, tbb = rb_ >> 14, eb = rb_ & 16383;
        const f32x4* pa = (const f32x4*)(a.in[17 + tba] + (size_t)ea * D) + lane; const f32x4* pb = (const f32x4*)(a.in[17 + tbb] + (size_t)eb * D) + lane;
        f32x4 va[8], vb[8];
#pragma unroll
        for (int m = 0; m < 8; ++m) va[m] = __builtin_nontemporal_load(pa + 64 * m);
#pragma unroll
        for (int m = 0; m < 8; ++m) vb[m] = __builtin_nontemporal_load(pb + 64 * m);
        const int su = (lane & 3) * 16 + (lane >> 2);
        fp4_pack_row(va, (unsigned*)(ws + (tba ? WS_EV : WS_EU) + (size_t)ea * 1024), ws + (tba ? WS_EV : WS_EU) + EXP_SC_OFF + (size_t)ea * 64, tba ? lane : su, lane);
        fp4_pack_row(vb, (unsigned*)(ws + (tbb ? WS_EV : WS_EU) + (size_t)eb * 1024), ws + (tbb ? WS_EV : WS_EU) + EXP_SC_OFF + (size_t)eb * 64, tbb ? lane : su, lane);
    }
    for (int m = gw; m < M + NMETA; m += 2 * NGW) {
        const int mb = (m + NGW < M + NMETA) ? m + NGW : m;
        const float* xa = m < M ? a.in[0] + (size_t)m * D : a.in[1] + (size_t)(m - M) * D; bf16_t* oa = m < M ? (bf16_t*)(ws + WS_H0) + (size_t)m * D : (bf16_t*)(ws + WS_HM) + (size_t)(m - M) * D;
        const float* xb = mb < M ? a.in[0] + (size_t)mb * D : a.in[1] + (size_t)(mb - M) * D; bf16_t* ob = mb < M ? (bf16_t*)(ws + WS_H0) + (size_t)mb * D : (bf16_t*)(ws + WS_HM) + (size_t)(mb - M) * D;
        ln_2rows(xa, oa, m < M ? (unsigned*)(ws + WS_H0_8 + (size_t)m * 2048) : nullptr, xb, ob, mb < M ? (unsigned*)(ws + WS_H0_8 + (size_t)mb * 2048) : nullptr, a.in[2], a.in[3], lane);
    }
    constexpr int I_WIN = (2048 / 64) * (8192 / 32), I_PP = (1024 / 64) * (2048 / 32), I_WO = (2048 / 64) * (2048 / 32);
    constexpr int NITEMS = I_WIN + I_PP + 2 * I_WO;
    for (int it = gw; it < NITEMS; it += NGW) {
        int r = it;
        if (r < I_WIN) { if ((r & 255) < 128) transpose_item(a.in[4], 8192, (bf16_t*)(ws + WS_WIN_T), 2048, 0, scr, r, lane); else transpose_item_fp8(a.in[4], 8192, ws + WS_WIN8, 4096, 64.0f, scr, r, lane); continue; } r -= I_WIN;
        if (r < I_PP) { transpose_item(a.in[10], 2048, (bf16_t*)(ws + WS_W2_T), 2048, 1024, scr, r, lane); continue; } r -= I_PP;
        if (r < I_WO) { transpose_item(a.in[11], 2048, (bf16_t*)(ws + WS_WO_T), 2048, 0, scr, r, lane); continue; } r -= I_WO;
        transpose_item_wq(a.in[14], (bf16_t*)(ws + WS_WQ_T), scr, r, lane, a.in[12], a.in[13], (float*)(ws + WS_POOLED), (float*)(ws + WS_POOLED + 256 * 1024));
    }
    for (int t = gw; t < 2048 && (gw & 1) == 1; t += NGW) {
        const int cin0 = (t >> 3) * 4, gI = cin0 >> 8, d0 = (t & 7) * 256 + lane; const float* pw = a.in[5] + (size_t)cin0 * 256; const float* psc = a.in[6] + gI * 256; const float* pp = a.in[7] + (size_t)(gI * 256) * 2048 + d0;
        float acc[4][4];
#pragma unroll
        for (int i = 0; i < 4; ++i)
#pragma unroll
            for (int j = 0; j < 4; ++j) acc[i][j] = 0.f;
        for (int c0 = 0; c0 < 256; c0 += 8) {
            float p[8][4];
#pragma unroll
            for (int cc = 0; cc < 8; ++cc)
#pragma unroll
                for (int j = 0; j < 4; ++j) p[cc][j] = pp[(size_t)(c0 + cc) * 2048 + 64 * j];
#pragma unroll
            for (int cc = 0; cc < 8; ++cc) {
                const int c = c0 + cc; const float sc = psc[c]; const float w0 = pw[c] * sc, w1 = pw[256 + c] * sc, w2 = pw[512 + c] * sc, w3 = pw[768 + c] * sc;
#pragma unroll
                for (int j = 0; j < 4; ++j) { acc[0][j] += w0 * p[cc][j]; acc[1][j] += w1 * p[cc][j]; acc[2][j] += w2 * p[cc][j]; acc[3][j] += w3 * p[cc][j]; }
            }
        }
        bf16_t* W2 = (bf16_t*)(ws + WS_W2_T);
#pragma unroll
        for (int j = 0; j < 4; ++j) { u32x2 o; o.x = pk2(acc[0][j], acc[1][j]); o.y = pk2(acc[2][j], acc[3][j]); *(u32x2*)(W2 + (size_t)(d0 + 64 * j) * 2048 + cin0) = o; }
    }
    const size_t gt = (size_t)blockIdx.x * NTH + tid, ngt = (size_t)gridDim.x * NTH;
    { unsigned long long* st = (unsigned long long*)(ws + WS_STATS); for (size_t i = gt; i < (size_t)2 * M; i += ngt) st[i] = 0ull; }
    cvt_flat(a.in[15], (bf16_t*)(ws + WS_KEYS), (size_t)8 * 128 * 128 / 8, gt, ngt);
    cvt_flat(a.in[16], (bf16_t*)(ws + WS_KEYS) + 8 * 128 * 128, (size_t)8 * 128 * 128 / 8, gt, ngt);
}
__device__ __forceinline__ void ln1_fold_vectors(const Args& a) {
    const int gid = blockIdx.x * NTH + threadIdx.x;
    if (gid >= 4096) return;
    const int which = gid >> 11, n = gid & 2047; const float* part = (const float*)(a.ws + WS_POOLED + (which ? 256 * 1024 : 0));
    float s = 0.f;
#pragma unroll
    for (int kb = 0; kb < 32; ++kb) s += part[(size_t)kb * 2048 + n];
    ((float*)(a.ws + (which ? WS_BW : WS_CS)))[n] = s;
}

__device__ __forceinline__ void meta_proj(const Args& a) {
    const int lane = threadIdx.x & 63, gw = blockIdx.x * NWAVE + (threadIdx.x >> 6), NGW = gridDim.x * NWAVE;
    for (int ci = gw; ci < 3072; ci += NGW) {
        const int seg = ci >> 10, c = ci & 1023, col = (seg == 0 ? 0 : (seg == 1 ? 1024 : 3072)) + c;
        const u32x4* wp = (const u32x4*)((const bf16_t*)(a.ws + WS_WIN_T) + (size_t)col * D + lane * 32);
        float wv[32];
#pragma unroll
        for (int q = 0; q < 4; ++q) { const u32x4 w = wp[q]; wv[8 * q + 0] = bflo(w.x); wv[8 * q + 1] = bfhi(w.x); wv[8 * q + 2] = bflo(w.y); wv[8 * q + 3] = bfhi(w.y); wv[8 * q + 4] = bflo(w.z); wv[8 * q + 5] = bfhi(w.z); wv[8 * q + 6] = bflo(w.w); wv[8 * q + 7] = bfhi(w.w); }
        float mine = 0.f;
#pragma unroll
        for (int r = 0; r < 16; ++r) {
            const u32x4* hp = (const u32x4*)((const bf16_t*)(a.ws + WS_HM) + (size_t)r * D + lane * 32);
            float s = 0.f;
#pragma unroll
            for (int q = 0; q < 4; ++q) { const u32x4 h = hp[q];
                s += bflo(h.x) * wv[8 * q + 0] + bfhi(h.x) * wv[8 * q + 1] + bflo(h.y) * wv[8 * q + 2] + bfhi(h.y) * wv[8 * q + 3] + bflo(h.z) * wv[8 * q + 4] + bfhi(h.z) * wv[8 * q + 5] + bflo(h.w) * wv[8 * q + 6] + bfhi(h.w) * wv[8 * q + 7]; }
            s = wave_sum(s);
            mine = (lane == r) ? s : mine;
        }
        if (lane < 16) ((float*)(a.ws + WS_PMETA))[(size_t)lane * 3072 + seg * 1024 + c] = mine;
    }
}

__device__ __forceinline__ void unpack8(const u32x4 v, float (&f)[8]) { f[0] = bflo(v.x); f[1] = bfhi(v.x); f[2] = bflo(v.y); f[3] = bfhi(v.y); f[4] = bflo(v.z); f[5] = bfhi(v.z); f[6] = bflo(v.w); f[7] = bfhi(v.w); }
__device__ __forceinline__ void load8_f32(const float* p, float (&f)[8]) { const f32x4 a = *(const f32x4*)p, b = *(const f32x4*)(p + 4); f[0] = a[0]; f[1] = a[1]; f[2] = a[2]; f[3] = a[3]; f[4] = b[0]; f[5] = b[1]; f[6] = b[2]; f[7] = b[3]; }
__device__ __forceinline__ void p2_get(const bf16_t* PAZ, const float* PMETA, int r, int s, int delta, int paz_col, int meta_col, float (&f)[8]) {
    if (s + delta >= 0) unpack8(*(const u32x4*)(PAZ + (size_t)(r + delta) * 4096 + paz_col), f);
    else load8_f32(PMETA + (size_t)(NMETA + s + delta) * 3072 + meta_col, f);
}
__device__ __forceinline__ void phase2(const Args& a) {
    const bf16_t* PAZ = (const bf16_t*)(a.ws + WS_PAZ); const float* PMETA = (const float*)(a.ws + WS_PMETA);
    bf16_t* A2 = (bf16_t*)(a.ws + WS_A2);
    const float* conv_w = a.in[8]; const float* conv_b = a.in[9];
    const int total = (M / 16) * 128;
    for (int idx = blockIdx.x * NTH + threadIdx.x; idx < total; idx += gridDim.x * NTH) {
        const int c8 = idx & 127, c = c8 * 8, r0 = (idx >> 7) * 16, s0 = r0 & (SEQ - 1);
        const int g = c8 >> 5, w = 2 << g; const float inv = 1.0f / (float)w;
        float S[8], u1[8], u2[8], w0[8], w1[8], w2[8], cb[8];
        load8_f32(conv_w + c, w0); load8_f32(conv_w + 1024 + c, w1); load8_f32(conv_w + 2048 + c, w2); load8_f32(conv_b + c, cb);
#pragma unroll
        for (int i = 0; i < 8; ++i) S[i] = 0.f;
        for (int j = 1; j <= w; ++j) { float f[8]; p2_get(PAZ, PMETA, r0, s0, -j, c, c, f);
#pragma unroll
            for (int i = 0; i < 8; ++i) S[i] += f[i]; }
        { float zh[8], zc[8]; p2_get(PAZ, PMETA, r0, s0, -1, 1024 + c, 1024 + c, zh); p2_get(PAZ, PMETA, r0, s0, -1, 3072 + c, 2048 + c, zc);
#pragma unroll
          for (int i = 0; i < 8; ++i) u1[i] = zh[i] * zc[i];
          p2_get(PAZ, PMETA, r0, s0, -2, 1024 + c, 1024 + c, zh); p2_get(PAZ, PMETA, r0, s0, -2, 3072 + c, 2048 + c, zc);
#pragma unroll
          for (int i = 0; i < 8; ++i) u2[i] = zh[i] * zc[i]; }
#pragma unroll 4
        for (int t = 0; t < 16; ++t) {
            const int r = r0 + t, s = s0 + t;
            float an[8], ao[8], zh[8], zc[8], zb[8];
            unpack8(*(const u32x4*)(PAZ + (size_t)r * 4096 + c), an);
            p2_get(PAZ, PMETA, r, s, -w, c, c, ao);
            unpack8(__builtin_nontemporal_load((const u32x4*)(PAZ + (size_t)r * 4096 + 1024 + c)), zh); unpack8(__builtin_nontemporal_load((const u32x4*)(PAZ + (size_t)r * 4096 + 2048 + c)), zb); unpack8(__builtin_nontemporal_load((const u32x4*)(PAZ + (size_t)r * 4096 + 3072 + c)), zc);
            float po[8], yo[8];
#pragma unroll
            for (int i = 0; i < 8; ++i) { S[i] += an[i] - ao[i]; po[i] = S[i] * inv - an[i];
                const float u0 = zh[i] * zc[i]; yo[i] = zb[i] * (cb[i] + w2[i] * u0 + w1[i] * u1[i] + w0[i] * u2[i]); u2[i] = u1[i]; u1[i] = u0; }
            u32x4 o; o.x = pk2(po[0], po[1]); o.y = pk2(po[2], po[3]); o.z = pk2(po[4], po[5]); o.w = pk2(po[6], po[7]);
            *(u32x4*)(A2 + (size_t)r * 2048 + c) = o;
            o.x = pk2(yo[0], yo[1]); o.y = pk2(yo[2], yo[3]); o.z = pk2(yo[4], yo[5]); o.w = pk2(yo[6], yo[7]);
            *(u32x4*)(A2 + (size_t)r * 2048 + 1024 + c) = o;
        }
    }
}

__device__ __forceinline__ void phase_ln1(const Args& a) {
    const int lane = threadIdx.x & 63, gw = blockIdx.x * NWAVE + (threadIdx.x >> 6), NGW = gridDim.x * NWAVE;
    bf16_t* R1 = (bf16_t*)(a.ws + WS_A2); const float* g = a.in[12]; const float* b = a.in[13];
    for (int m = gw; m < M; m += NGW) {
        u32x4* rp = (u32x4*)(R1 + (size_t)m * D) + lane;
        float v[4][8]; float s = 0.f;
#pragma unroll
        for (int j = 0; j < 4; ++j) { unpack8(rp[64 * j], v[j]);
#pragma unroll
            for (int i = 0; i < 8; ++i) s += v[j][i]; }
        const float mean = wave_sum(s) * (1.f / D); float s2 = 0.f;
#pragma unroll
        for (int j = 0; j < 4; ++j)
#pragma unroll
            for (int i = 0; i < 8; ++i) { v[j][i] -= mean; s2 += v[j][i] * v[j][i]; }
        const float rstd = rsqrtf(wave_sum(s2) * (1.f / D) + LN_EPS);
#pragma unroll
        for (int j = 0; j < 4; ++j) { float gg[8], bb[8]; load8_f32(g + j * 512 + lane * 8, gg); load8_f32(b + j * 512 + lane * 8, bb);
            float y[8];
#pragma unroll
            for (int i = 0; i < 8; ++i) y[i] = v[j][i] * rstd * gg[i] + bb[i];
            u32x4 o; o.x = pk2(y[0], y[1]); o.y = pk2(y[2], y[3]); o.z = pk2(y[4], y[5]); o.w = pk2(y[6], y[7]); rp[64 * j] = o; }
    }
}

__host__ __device__ constexpr int stair_code(int idx) {
    int cnt = 0;
    for (int aa = 0; aa < 16; ++aa) for (int bb = 0; bb < 16; ++bb) if ((aa + 1) * (bb + 1) <= 16) { if (cnt == idx) return aa * 16 + bb; ++cnt; }
    return 0;
}
__device__ __forceinline__ unsigned umax_(unsigned a, unsigned b) { return a > b ? a : b; }
__device__ __forceinline__ unsigned umin_(unsigned a, unsigned b) { return a < b ? a : b; }
__device__ __forceinline__ void bitonic_sort16_desc(unsigned (&v)[16]) {
#pragma unroll
    for (int k = 2; k <= 16; k <<= 1)
#pragma unroll
        for (int j = k >> 1; j > 0; j >>= 1)
#pragma unroll
            for (int i = 0; i < 16; ++i) { const int l = i ^ j;
                if (l > i) { const unsigned a = v[i], b = v[l], mx = umax_(a, b), mn = umin_(a, b); const bool desc = ((i & k) == 0); v[i] = desc ? mx : mn; v[l] = desc ? mn : mx; } }
}
__device__ __forceinline__ void merge_top16(unsigned (&a)[16], const unsigned (&b)[16]) {
#pragma unroll
    for (int i = 0; i < 16; ++i) a[i] = umax_(a[i], b[15 - i]);
#pragma unroll
    for (int j = 8; j > 0; j >>= 1)
#pragma unroll
        for (int i = 0; i < 16; ++i) { const int l = i ^ j; if (l > i) { const unsigned x = a[i], y = a[l]; a[i] = umax_(x, y); a[l] = umin_(x, y); } }
}

__device__ __forceinline__ void p7_task(const bf16_t* Q, const LAS unsigned char* kl  , int* IDX, float* GATE, LAS unsigned* wl, int grp, int h, int lane) {
    const int tk = lane & 31, hh = lane >> 5, token = grp * 32 + tk;
#pragma unroll 1
    for (int side = 0; side < 2; ++side) {
        f32x16 acc[4];
#pragma unroll
        for (int nb = 0; nb < 4; ++nb)
#pragma unroll
            for (int r = 0; r < 16; ++r) acc[nb][r] = 0.f;
        const bf16_t* qp = Q + (size_t)token * D + h * 256 + side * 128 + 8 * hh;
        const LAS unsigned char* kp = kl + side * 32768 + tk * 256;
#pragma unroll
        for (int ks = 0; ks < 8; ++ks) {
            const bf16x8 bq = *(const bf16x8*)(qp + ks * 16);
#pragma unroll
            for (int nb = 0; nb < 4; ++nb) {
                const bf16x8 ak = *(const LAS bf16x8*)(kp + nb * 8192 + (((2 * ks + hh) ^ (tk & 15)) << 4));
                acc[nb] = __builtin_amdgcn_mfma_f32_32x32x16_bf16(ak, bq, acc[nb], 0, 0, 0);
            }
        }
        unsigned pk[4][16];
#pragma unroll
        for (int nb = 0; nb < 4; ++nb)
#pragma unroll
            for (int r = 0; r < 16; ++r) { const unsigned n = (unsigned)(nb * 32 + (r & 3) + 8 * (r >> 2)) + 4u * (unsigned)hh; pk[nb][r] = (ord_f32(acc[nb][r]) & ~127u) | (127u - n); }
        bitonic_sort16_desc(pk[0]); bitonic_sort16_desc(pk[1]); bitonic_sort16_desc(pk[2]); bitonic_sort16_desc(pk[3]);
        merge_top16(pk[0], pk[1]); merge_top16(pk[2], pk[3]); merge_top16(pk[0], pk[2]);
        unsigned pb[16];
#pragma unroll
        for (int i = 0; i < 16; ++i) { const auto sw = __builtin_amdgcn_permlane32_swap(pk[0][i], pk[0][i], false, false); pb[i] = hh ? sw[0] : sw[1]; }
        merge_top16(pk[0], pb);
        if (hh == 0) {
#pragma unroll
            for (int i = 0; i < 16; ++i) wl[(side * 32 + tk) * 16 + i] = pk[0][i];
        }
    }
    unsigned ck[25];
#define P7_CK(i) { constexpr int c0 = stair_code(2 * (i)), c1 = stair_code(2 * (i) + 1); const int cc = hh ? c1 : c0; const int ca = cc >> 4, cb = cc & 15; \
        const unsigned v1 = wl[(0 * 32 + tk) * 16 + ca], v2 = wl[(1 * 32 + tk) * 16 + cb]; const float sm = unord_f32(v1 & ~127u) + unord_f32(v2 & ~127u); \
        ck[i] = (ord_f32(sm) & ~255u) | (255u - (unsigned)cc); }
    P7_CK(0) P7_CK(1) P7_CK(2) P7_CK(3) P7_CK(4) P7_CK(5) P7_CK(6) P7_CK(7) P7_CK(8) P7_CK(9) P7_CK(10) P7_CK(11) P7_CK(12)
    P7_CK(13) P7_CK(14) P7_CK(15) P7_CK(16) P7_CK(17) P7_CK(18) P7_CK(19) P7_CK(20) P7_CK(21) P7_CK(22) P7_CK(23) P7_CK(24)
#undef P7_CK
#pragma unroll 1
    for (int rd = 0; rd < 16; ++rd) {
        unsigned m = ck[0];
#pragma unroll
        for (int i = 1; i < 25; ++i) m = umax_(m, ck[i]);
        m = umax_(m, (unsigned)__shfl_xor((int)m, 32));
#pragma unroll
        for (int i = 0; i < 25; ++i) ck[i] = (ck[i] == m) ? 0u : ck[i];
        if (hh == 0) wl[1024 + tk * 16 + rd] = m;
    }
    const float s0 = unord_f32(wl[1024 + tk * 16] & ~255u);
    float p0, p1, p2, p3, p4, p5, p6, p7; int e0, e1, e2, e3, e4, e5, e6, e7;
#define P7_FIN(r, pv, evv) { const unsigned m = wl[1024 + tk * 16 + 8 * hh + (r)]; const unsigned code = 255u - (m & 255u); const int ca = (int)(code >> 4), cb = (int)(code & 15u); \
        const unsigned v1 = wl[(0 * 32 + tk) * 16 + ca], v2 = wl[(1 * 32 + tk) * 16 + cb]; \
        pv = __expf(unord_f32(m & ~255u) - s0); evv = (int)(127u - (v1 & 127u)) * 128 + (int)(127u - (v2 & 127u)); }
    P7_FIN(0, p0, e0) P7_FIN(1, p1, e1) P7_FIN(2, p2, e2) P7_FIN(3, p3, e3) P7_FIN(4, p4, e4) P7_FIN(5, p5, e5) P7_FIN(6, p6, e6) P7_FIN(7, p7, e7)
#undef P7_FIN
    float Z = ((p0 + p1) + (p2 + p3)) + ((p4 + p5) + (p6 + p7));
    Z += __shfl_xor(Z, 32);
    const float iz = 1.0f / Z;
    int* ip = IDX + (size_t)token * 128 + h * 16 + hh * 8; float* gp = GATE + (size_t)token * 128 + h * 16 + hh * 8;
    ip[0] = e0; ip[1] = e1; ip[2] = e2; ip[3] = e3; ip[4] = e4; ip[5] = e5; ip[6] = e6; ip[7] = e7;
    gp[0] = p0 * iz; gp[1] = p1 * iz; gp[2] = p2 * iz; gp[3] = p3 * iz; gp[4] = p4 * iz; gp[5] = p5 * iz; gp[6] = p6 * iz; gp[7] = p7 * iz;
}
__device__ __forceinline__ void phase7(const Args& a, LAS unsigned char* lds) {
    const int tid = threadIdx.x, lane = tid & 63, wave = tid >> 6;
    const int h = blockIdx.x & 7, bq = blockIdx.x >> 3, nbh = ((int)gridDim.x - h + 7) >> 3;
    const bf16_t* KEYS = (const bf16_t*)(a.ws + WS_KEYS);
    for (int i = tid; i < 4096; i += NTH) { const int s = i >> 11, n = (i >> 4) & 127, c8 = i & 15;
        const u32x4 v = *(const u32x4*)(KEYS + ((size_t)(s * 8 + h) * 128 + n) * 128 + c8 * 8);
        *(LAS u32x4*)(lds + s * 32768 + n * 256 + ((c8 ^ (n & 15)) << 4)) = v; }
    __syncthreads();
    LAS unsigned* wl = (LAS unsigned*)(lds + 65536 + wave * 8192);
    const bf16_t* Q = (const bf16_t*)(a.ws + WS_PAZ + 64 * MiB);
    int* IDX = (int*)(a.ws + WS_POOLED); float* GATE = (float*)(a.ws + WS_POOLED + 8 * MiB);
    for (int g = bq * NWAVE + wave; g < M / 32; g += nbh * NWAVE) p7_task(Q, lds, IDX, GATE, wl, g, h, lane);
    __syncthreads();
}

typedef float f32x2 __attribute__((ext_vector_type(2)));
#ifndef P8_AUX
#define P8_AUX 0
#endif
template <int CTRL> __device__ __forceinline__ float dpp_f(float v) { return __int_as_float(__builtin_amdgcn_update_dpp(0, __float_as_int(v), CTRL, 0xf, 0xf, false)); }
struct UGrp { int t0, t1, t2, t3, pkr; };
constexpr int U_WAVE_LDS = 20304;
__device__ __forceinline__ void phase_u(const Args& a, LAS unsigned char* lds) {
    typedef int v8i_ __attribute__((ext_vector_type(8)));
    int lane = threadIdx.x & 63; const int wave = __builtin_amdgcn_readfirstlane((int)(threadIdx.x >> 6)), gw = blockIdx.x * NWAVE + wave, NGW = gridDim.x * NWAVE;
    LAS unsigned char* wl = lds + wave * U_WAVE_LDS;
    LAS unsigned short* elist = (LAS unsigned short*)(wl + 17408);
    LAS int* offT = (LAS int*)(wl + 19456);
    LAS unsigned short* cst = (LAS unsigned short*)(wl + 20032);
    const bf16_t* R1 = (const bf16_t*)(a.ws + WS_A2);
    int* IDX = (int*)(a.ws + WS_POOLED); float* GATE = (float*)(a.ws + WS_POOLED + 8 * MiB); float* ACT = (float*)(a.ws + WS_POOLED + 16 * MiB);
    float* dump = (float*)(a.ws + WS_POOLED + 24 * MiB) + (size_t)gw * 64;
    const __amdgpu_buffer_rsrc_t ru = __builtin_amdgcn_make_buffer_rsrc((void*)(a.ws + WS_EU), 0, 16 * 1024 * 1024, 0x00020000);
    const __amdgpu_buffer_rsrc_t rsc = __builtin_amdgcn_make_buffer_rsrc((void*)(a.ws + WS_EU + EXP_SC_OFF), 0, 1024 * 1024, 0x00020000);
#pragma unroll 1
    for (int tb = gw; tb < M / 8; tb += NGW) {
        const int tok0 = __builtin_amdgcn_readfirstlane(tb * 8);
        int el[8], eh[8]; float gl[8], gh[8];
#pragma unroll
        for (int t = 0; t < 8; ++t) { const size_t o = (size_t)(tok0 + t) * 128; el[t] = IDX[o + lane]; eh[t] = IDX[o + 64 + lane]; gl[t] = GATE[o + lane]; gh[t] = GATE[o + 64 + lane]; }
#pragma unroll
        for (int t = 0; t < 8; ++t) {
            const size_t o = (size_t)(tok0 + t) * 128;
            const int e_lo = el[t], e_hi = eh[t]; const float g_lo = gl[t], g_hi = gh[t];
            const int b_lo = e_lo >> 10, b_hi = e_hi >> 10; int base = 0, pos_lo = 0, pos_hi = 0;
#pragma unroll 1
            for (int b = 0; b < 16; ++b) {
                const unsigned long long m0 = __ballot(b_lo == b), m1 = __ballot(b_hi == b);
                const int c0 = __popcll(m0), c1 = __popcll(m1);
                const int r0 = __builtin_amdgcn_mbcnt_hi((unsigned)(m0 >> 32), __builtin_amdgcn_mbcnt_lo((unsigned)m0, 0u));
                const int r1 = __builtin_amdgcn_mbcnt_hi((unsigned)(m1 >> 32), __builtin_amdgcn_mbcnt_lo((unsigned)m1, 0u));
                if (lane == 0) offT[t * 18 + b] = base;
                pos_lo = (b_lo == b) ? base + r0 : pos_lo; pos_hi = (b_hi == b) ? base + c0 + r1 : pos_hi;
                base += c0 + c1;
            }
            if (lane == 0) offT[t * 18 + 16] = 128;
            IDX[o + pos_lo] = e_lo; IDX[o + pos_hi] = e_hi; GATE[o + pos_lo] = g_lo; GATE[o + pos_hi] = g_hi;
            elist[t * 128 + pos_lo] = (unsigned short)e_lo; elist[t * 128 + pos_hi] = (unsigned short)e_hi;
        }
        asm volatile("s_waitcnt lgkmcnt(0)" ::: "memory");
        { const int c0i = 2 * lane, bb = c0i >> 3, t0 = c0i & 7;
          const int n0 = offT[t0 * 18 + bb + 1] - offT[t0 * 18 + bb], n1 = offT[(t0 + 1) * 18 + bb + 1] - offT[(t0 + 1) * 18 + bb];
          int inc = n0 + n1;
#pragma unroll
          for (int o = 1; o < 64; o <<= 1) { const int up = __shfl_up(inc, o); inc += (lane >= o) ? up : 0; }
          const int pre = inc - (n0 + n1);
          cst[c0i] = (unsigned short)pre; cst[c0i + 1] = (unsigned short)(pre + n0);
          if (lane == 63) cst[128] = (unsigned short)1024; }
        asm volatile("s_waitcnt lgkmcnt(0)" ::: "memory");
        v8i_ XF[16];
#pragma unroll
        for (int j = 0; j < 16; ++j) XF[j] = (v8i_){0, 0, 0, 0, 0, 0, 0, 0};
        {
            asm volatile("" : "+v"(lane));
            const int n16 = lane & 15, kq = lane >> 4;
            const int wbase = (lane >> 2) * 128 + (lane & 1) * 64 + ((lane >> 1) & 1) * 16;
            const int rbase = ((n16 >> 1) & 3) * 4096 + (n16 & 1) * 2048 + kq * 32;
            const f32x4* g14 = (const f32x4*)a.in[12] + lane; const f32x4* b14 = (const f32x4*)a.in[13] + lane;
            u32x2 rw[8]; long long st_s, st_q;
            { const long long* st1 = (const long long*)(a.ws + WS_STATS) + 2 * (size_t)tok0; st_s = st1[0]; st_q = st1[1];
              const u32x2* hp = (const u32x2*)(R1 + (size_t)tok0 * D) + lane;
#pragma unroll
              for (int m = 0; m < 8; ++m) rw[m] = hp[64 * m]; }
#pragma unroll 1
            for (int k = 0; k < 8; ++k) {
                const int tt = k & 3, hh = k >> 2, tokn = tok0 + (k < 7 ? k + 1 : k);
                u32x2 rn[8]; long long sn_s, sn_q;
                { const long long* st1 = (const long long*)(a.ws + WS_STATS) + 2 * (size_t)tokn; sn_s = st1[0]; sn_q = st1[1];
                  const u32x2* hp = (const u32x2*)(R1 + (size_t)tokn * D) + lane;
#pragma unroll
                  for (int m = 0; m < 8; ++m) rn[m] = hp[64 * m]; }
                const float sm1 = i64f(st_s) * (1.0f / STAT_FX), sq1 = i64f(st_q) * (1.0f / STAT_FX);
                const float mean1 = sm1 * (1.0f / D), rstd1 = rsqrtf(fmaxf(sq1 * (1.0f / D) - mean1 * mean1, 0.f) + LN_EPS);
#pragma unroll
                for (int m = 0; m < 8; ++m) { const u32x2 w = rw[m]; const f32x4 gg = g14[64 * m], bb = b14[64 * m];
                    const float x0 = (bflo(w.x) - mean1) * rstd1 * gg[0] + bb[0], x1 = (bfhi(w.x) - mean1) * rstd1 * gg[1] + bb[1], x2 = (bflo(w.y) - mean1) * rstd1 * gg[2] + bb[2], x3 = (bfhi(w.y) - mean1) * rstd1 * gg[3] + bb[3];
                    int hi = 0; hi = __builtin_amdgcn_cvt_pk_fp8_f32(x0, x1, hi, false); hi = __builtin_amdgcn_cvt_pk_fp8_f32(x2, x3, hi, true);
                    const f32x2 h01 = __builtin_amdgcn_cvt_pk_f32_fp8(hi, false), h23 = __builtin_amdgcn_cvt_pk_f32_fp8(hi, true);
                    int lo = 0; lo = __builtin_amdgcn_cvt_pk_fp8_f32((x0 - h01.x) * 32.0f, (x1 - h01.y) * 32.0f, lo, false); lo = __builtin_amdgcn_cvt_pk_fp8_f32((x2 - h23.x) * 32.0f, (x3 - h23.y) * 32.0f, lo, true);
                    LAS int* wp = (LAS int*)(wl + tt * 4096 + wbase + (m >> 2) * 32 + (m & 3) * 4);
                    wp[0] = hi; wp[512] = lo; }
                if (tt == 3) {
                    asm volatile("s_waitcnt lgkmcnt(0)" ::: "memory");
                    if ((n16 >> 3) == hh) {
#pragma unroll
                        for (int j = 0; j < 16; ++j) { const u32x4 q0 = *(const LAS u32x4*)(wl + rbase + j * 128), q1 = *(const LAS u32x4*)(wl + rbase + j * 128 + 16);
                            XF[j] = (v8i_){(int)q0[0], (int)q0[1], (int)q0[2], (int)q0[3], (int)q1[0], (int)q1[1], (int)q1[2], (int)q1[3]}; }
                    }
                    asm volatile("s_waitcnt lgkmcnt(0)" ::: "memory");
                }
#pragma unroll
                for (int m = 0; m < 8; ++m) rw[m] = rn[m];
                st_s = sn_s; st_q = sn_q;
            }
        }
        asm volatile("" : "+v"(lane));
        const int n16 = lane & 15, kq = lane >> 4;
        int rb[4];
#pragma unroll
        for (int jj = 0; jj < 4; ++jj) rb[jj] = n16 * 256 + (4 * (jj ^ (n16 >> 2)) + (kq ^ (n16 & 3))) * 16;
        const int xbase = ((lane & 15) ^ (lane >> 4)) * 16;
        const int scrd = 16384 + n16 * 64 + kq * 16;
        const int bscale = (n16 & 1) ? 0x7A : 0x7F;
        int rnd = -1, g = 3;
        int e_vec = 0, pk_vec = -1;
        auto advance = [&]() __attribute__((always_inline)) -> bool {
            ++g; if (g < 4) return true;
            ++rnd; if (rnd >= 16) return false;
            const int q = 64 * rnd + lane; int c = 0, base = 0;
#pragma unroll
            for (int step = 64; step >= 1; step >>= 1) { const int v = (int)cst[c + step]; const bool ge = v <= q; c = ge ? c + step : c; base = ge ? v : base; }
            const int t = c & 7, pos = offT[t * 18 + (c >> 3)] + (q - base);
            e_vec = (int)elist[t * 128 + pos]; pk_vec = t * 128 + pos;
            g = 0; return true;
        };
        int vo[4], vsc;
        auto prepare = [&](UGrp& G) __attribute__((always_inline)) {
            const int l0 = 16 * g, tb4 = 4 * (l0 + 4 * kq);
            G.t0 = __builtin_amdgcn_ds_bpermute(tb4, pk_vec); G.t1 = __builtin_amdgcn_ds_bpermute(tb4 + 4, pk_vec); G.t2 = __builtin_amdgcn_ds_bpermute(tb4 + 8, pk_vec); G.t3 = __builtin_amdgcn_ds_bpermute(tb4 + 12, pk_vec);
            G.pkr = __builtin_amdgcn_ds_bpermute(tb4 + 4 * (n16 & 3), pk_vec);
#pragma unroll
            for (int i = 0; i < 4; ++i) vo[i] = __builtin_amdgcn_ds_bpermute(4 * (l0 + 4 * i + kq), e_vec) * 1024 + (xbase ^ (64 * i));
            vsc = __builtin_amdgcn_ds_bpermute(4 * (l0 + (lane >> 2)), e_vec) * 64 + (lane & 3) * 16;
        };
#define U_SCDMA() __builtin_amdgcn_raw_ptr_buffer_load_lds(rsc, (LAS unsigned*)(wl + 16384), 16, vsc, 0, 0, 0)
#define U_DMA(q) { _Pragma("unroll") for (int i = 0; i < 4; ++i) __builtin_amdgcn_raw_ptr_buffer_load_lds(ru, (LAS unsigned*)(wl + (q) * 4096 + i * 1024), 16, vo[i], (q) * 256, 0, 0); }
#define U_MMA(j) { const u32x4 qa = *(const LAS u32x4*)(wl + rb[(j) & 3] + ((j) >> 2) * 4096); const v8i_ a8 = (v8i_){(int)qa[0], (int)qa[1], (int)qa[2], (int)qa[3], 0, 0, 0, 0}; \
            acc = __builtin_amdgcn_mfma_scale_f32_16x16x128_f8f6f4(a8, XF[j], acc, 4  , 0  , (j) & 3  , (int)SCr[(j) >> 2], 0, bscale); }
#define U_Q(q) { U_MMA(4 * (q)) U_MMA(4 * (q) + 1) U_MMA(4 * (q) + 2) U_MMA(4 * (q) + 3) asm volatile("s_waitcnt lgkmcnt(0)" : "+v"(acc) :: "memory"); __builtin_amdgcn_sched_barrier(0); }
#define U_WAIT(n) asm volatile("s_waitcnt vmcnt(" #n ")" ::: "memory")
        UGrp Gc, Gn; int it = 0; float sacc = 0.f; int pkacc = -1;
        bool more = advance();
        prepare(Gc);
        U_SCDMA(); U_DMA(0) U_DMA(1) U_DMA(2) U_DMA(3)
#pragma unroll 1
        for (;;) {
            more = advance();
            if (more) prepare(Gn);
            __builtin_amdgcn_sched_barrier(0);
            if (!more) U_WAIT(0); else if (it == 0) U_WAIT(12); else U_WAIT(13);
            const u32x4 SCr = *(const LAS u32x4*)(wl + scrd);
            asm volatile("s_waitcnt lgkmcnt(0)" ::: "memory");
            f32x4 acc = (f32x4){0.f, 0.f, 0.f, 0.f};
            U_Q(0) if (more) { U_SCDMA(); U_DMA(0) if (it == 0) U_WAIT(13); else U_WAIT(14); }
            U_Q(1) if (more) { U_DMA(1) if (it == 0) U_WAIT(13); else U_WAIT(14); }
            U_Q(2) if (more) { U_DMA(2) if (it == 0) U_WAIT(13); else U_WAIT(14); }
            U_Q(3) if (more) { U_DMA(3) }
            asm volatile("s_nop 15\n\ts_nop 15" : "+v"(acc));
            const int tsl = n16 >> 1;
            float v0 = ((Gc.t0 >> 7) == tsl) ? acc[0] : 0.f, v1 = ((Gc.t1 >> 7) == tsl) ? acc[1] : 0.f, v2 = ((Gc.t2 >> 7) == tsl) ? acc[2] : 0.f, v3 = ((Gc.t3 >> 7) == tsl) ? acc[3] : 0.f;
            v0 += dpp_f<0xB1>(v0); v1 += dpp_f<0xB1>(v1); v2 += dpp_f<0xB1>(v2); v3 += dpp_f<0xB1>(v3);
            v0 += dpp_f<0x4E>(v0); v1 += dpp_f<0x4E>(v1); v2 += dpp_f<0x4E>(v2); v3 += dpp_f<0x4E>(v3);
            v0 += dpp_f<0x141>(v0); v1 += dpp_f<0x141>(v1); v2 += dpp_f<0x141>(v2); v3 += dpp_f<0x141>(v3);
            v0 += dpp_f<0x140>(v0); v1 += dpp_f<0x140>(v1); v2 += dpp_f<0x140>(v2); v3 += dpp_f<0x140>(v3);
            const float s01 = (n16 & 1) ? v1 : v0, s23 = (n16 & 1) ? v3 : v2, s = (n16 & 2) ? s23 : s01;
            const bool mine = (n16 >> 2) == (it & 3);
            sacc = mine ? s : sacc; pkacc = mine ? Gc.pkr : pkacc;
            float* dst = dump + lane; float val = 0.f;
            if ((it & 3) == 3 || !more) { val = gelu_erf(sacc); dst = pkacc >= 0 ? ACT + (size_t)tok0 * 128 + pkacc : dst; pkacc = -1; }
            *dst = val;
            if (!more) break;
            Gc = Gn; ++it;
        }
#undef U_MMA
#undef U_Q
#undef U_DMA
#undef U_SCDMA
#undef U_WAIT
        asm volatile("s_waitcnt vmcnt(0) lgkmcnt(0)" ::: "memory");
    }
}

struct RowBufV { u32x4 v; unsigned s; };
__device__ __forceinline__ void p8v_load(RowBufV& b, const __amdgpu_buffer_rsrc_t rv, int e, int lane) {
    b.v = __builtin_amdgcn_raw_buffer_load_b128(rv, lane * 16, e * 1024, P8_AUX); b.s = __builtin_amdgcn_raw_buffer_load_b8(rv, lane, (int)EXP_SC_OFF + e * 64, 0);
}
__device__ __forceinline__ void p8v_axpy(const RowBufV& b, float c, f32x2 (&y)[8][2]) {
    const float sc = __uint_as_float((b.s & 0xffu) << 23);
    const f32x2 c2 = (f32x2){c, c};
#pragma unroll
    for (int d = 0; d < 4; ++d) {
        const f32x2 p0 = __builtin_amdgcn_cvt_scalef32_pk_f32_fp4(b.v[d], sc, 0), p1 = __builtin_amdgcn_cvt_scalef32_pk_f32_fp4(b.v[d], sc, 1);
        const f32x2 p2 = __builtin_amdgcn_cvt_scalef32_pk_f32_fp4(b.v[d], sc, 2), p3 = __builtin_amdgcn_cvt_scalef32_pk_f32_fp4(b.v[d], sc, 3);
        y[2 * d][0] = __builtin_elementwise_fma(c2, p0, y[2 * d][0]); y[2 * d][1] = __builtin_elementwise_fma(c2, p1, y[2 * d][1]);
        y[2 * d + 1][0] = __builtin_elementwise_fma(c2, p2, y[2 * d + 1][0]); y[2 * d + 1][1] = __builtin_elementwise_fma(c2, p3, y[2 * d + 1][1]);
    }
}
constexpr int VG = 4;
__device__ __forceinline__ void p8v_load_group(RowBufV (&R)[VG], const __amdgpu_buffer_rsrc_t rv, int e_lo, int e_hi, int g, int lane) {
    const int ev = g < 64 / VG ? e_lo : e_hi, kb = (VG * g) & 63;
#pragma unroll
    for (int i = 0; i < VG; ++i) p8v_load(R[i], rv, __builtin_amdgcn_readlane(ev, kb + i), lane);
}
__device__ __forceinline__ void p8v_group(const RowBufV (&R)[VG], int g, int c_lo, int c_hi, f32x2 (&y)[8][2]) {
    const int cv = g < 64 / VG ? c_lo : c_hi, kb = (VG * g) & 63;
#pragma unroll
    for (int i = 0; i < VG; ++i) p8v_axpy(R[i], __int_as_float(__builtin_amdgcn_readlane(cv, kb + i)), y);
}
__device__ __forceinline__ void pv_epilogue(const Args& a, int token, f32x2 (&y)[8][2], int lane) {
    const bf16_t* R1 = (const bf16_t*)(a.ws + WS_A2);
    u32x2 r1w[8];
    { const u32x2* hp = (const u32x2*)(R1 + (size_t)token * D) + lane;
#pragma unroll
      for (int m = 0; m < 8; ++m) r1w[m] = hp[64 * m]; }
    const long long* st1 = (const long long*)(a.ws + WS_STATS) + 2 * (size_t)token;
    const float sm1 = i64f(st1[0]) * (1.0f / STAT_FX), sq1 = i64f(st1[1]) * (1.0f / STAT_FX);
    const float mean1 = sm1 * (1.0f / D), rstd1 = rsqrtf(fmaxf(sq1 * (1.0f / D) - mean1 * mean1, 0.f) + LN_EPS);
    const f32x4* g14 = (const f32x4*)a.in[12] + lane; const f32x4* b14 = (const f32x4*)a.in[13] + lane;
    float s = 0.f;
#pragma unroll
    for (int m = 0; m < 8; ++m) { const u32x2 w = r1w[m]; const f32x4 gg = g14[64 * m], bb = b14[64 * m];
        const f32x2 ha = (f32x2){(bflo(w.x) - mean1) * rstd1 * gg[0] + bb[0], (bfhi(w.x) - mean1) * rstd1 * gg[1] + bb[1]}, hc = (f32x2){(bflo(w.y) - mean1) * rstd1 * gg[2] + bb[2], (bfhi(w.y) - mean1) * rstd1 * gg[3] + bb[3]};
        y[m][0] = y[m][0] + ALPHA * ha; y[m][1] = y[m][1] + ALPHA * hc;
        s += (y[m][0].x + y[m][0].y) + (y[m][1].x + y[m][1].y); }
    const float mean = wave_sum(s) * (1.f / D); float s2 = 0.f;
#pragma unroll
    for (int m = 0; m < 8; ++m)
#pragma unroll
        for (int h = 0; h < 2; ++h) { y[m][h] = y[m][h] - mean; s2 += y[m][h].x * y[m][h].x + y[m][h].y * y[m][h].y; }
    const float rstd = rsqrtf(wave_sum(s2) * (1.f / D) + LN_EPS);
    const f32x4* g4 = (const f32x4*)a.in[19] + lane; const f32x4* b4 = (const f32x4*)a.in[20] + lane; f32x4* o4 = (f32x4*)(a.out + (size_t)token * D) + lane;
#pragma unroll
    for (int m = 0; m < 8; ++m) { const f32x4 gg = g4[64 * m], bb = b4[64 * m];
        f32x4 o; o[0] = y[m][0].x * rstd * gg[0] + bb[0]; o[1] = y[m][0].y * rstd * gg[1] + bb[1]; o[2] = y[m][1].x * rstd * gg[2] + bb[2]; o[3] = y[m][1].y * rstd * gg[3] + bb[3];
        __builtin_nontemporal_store(o, o4 + 64 * m); }
}
__device__ __forceinline__ void phase_v(const Args& a, LAS unsigned char* lds) {
    int lane = threadIdx.x & 63; const int wave = threadIdx.x >> 6, gw = blockIdx.x * NWAVE + wave, NGW = gridDim.x * NWAVE;
    const __amdgpu_buffer_rsrc_t rv = __builtin_amdgcn_make_buffer_rsrc((void*)(a.ws + WS_EV), 0, 17 * 1024 * 1024, 0x00020000);
    const int* IDX = (const int*)(a.ws + WS_POOLED); const float* GATE = (const float*)(a.ws + WS_POOLED + 8 * MiB); const float* ACT = (const float*)(a.ws + WS_POOLED + 16 * MiB);
    constexpr int NG = 128 / VG;
#pragma unroll 1
    for (int pr = gw; pr < M / 2; pr += NGW) {
        asm volatile("" : "+v"(lane));
        const int tA = __builtin_amdgcn_readfirstlane(2 * pr), tB = tA + 1;
        const size_t oA = (size_t)tA * 128, oB = (size_t)tB * 128;
        const int eA_lo = IDX[oA + lane], eA_hi = IDX[oA + 64 + lane], eB_lo = IDX[oB + lane], eB_hi = IDX[oB + 64 + lane];
        const int cA_lo = __float_as_int(GATE[oA + lane] * ACT[oA + lane]), cA_hi = __float_as_int(GATE[oA + 64 + lane] * ACT[oA + 64 + lane]);
        const int cB_lo = __float_as_int(GATE[oB + lane] * ACT[oB + lane]), cB_hi = __float_as_int(GATE[oB + 64 + lane] * ACT[oB + 64 + lane]);
        f32x2 yA[8][2], yB[8][2];
#pragma unroll
        for (int m = 0; m < 8; ++m) { yA[m][0] = (f32x2){0.f, 0.f}; yA[m][1] = (f32x2){0.f, 0.f}; yB[m][0] = (f32x2){0.f, 0.f}; yB[m][1] = (f32x2){0.f, 0.f}; }
        RowBufV R0[VG], R1b[VG], R2[VG], R3[VG];
        p8v_load_group(R0, rv, eA_lo, eA_hi, 0, lane); p8v_load_group(R1b, rv, eB_lo, eB_hi, 0, lane); p8v_load_group(R2, rv, eA_lo, eA_hi, 1, lane);
#define PV_LD(buf, el, eh, grp) do { if ((grp) < NG) p8v_load_group(buf, rv, el, eh, (grp), lane); __builtin_amdgcn_sched_barrier(0); } while (0)
#define PV_CP(buf, cl, ch, grp, yy) do { if ((grp) < NG) p8v_group(buf, (grp), cl, ch, yy); __builtin_amdgcn_sched_barrier(0); } while (0)
#pragma unroll 1
        for (int k = 0; 2 * k < NG; ++k) {
            PV_LD(R3,  eB_lo, eB_hi, 2 * k + 1); PV_CP(R0,  cA_lo, cA_hi, 2 * k,     yA);
            PV_LD(R0,  eA_lo, eA_hi, 2 * k + 2); PV_CP(R1b, cB_lo, cB_hi, 2 * k,     yB);
            PV_LD(R1b, eB_lo, eB_hi, 2 * k + 2); PV_CP(R2,  cA_lo, cA_hi, 2 * k + 1, yA);
            PV_LD(R2,  eA_lo, eA_hi, 2 * k + 3); PV_CP(R3,  cB_lo, cB_hi, 2 * k + 1, yB);
        }
#undef PV_LD
#undef PV_CP
        asm volatile("" : "+v"(lane));
        pv_epilogue(a, tA, yA, lane);
        pv_epilogue(a, tB, yB, lane);
    }
}

#define XB_TMO      128
#define XB_XCNT(j)  (256  + 64 * (j))
#define XB_XSUB(j)  (1280 + 64 * (j))
#define XB_XGEN(j)  (2304 + 64 * (j))
#define XB_TOP      3328
#define XB_TOPGEN   3392
#define XCD_BAR_WORDS 3456
#define XB_SPIN_CAP (1u << 18)
__device__ __forceinline__ unsigned xb_ld(unsigned* p)              { return __hip_atomic_load(p, __ATOMIC_RELAXED, __HIP_MEMORY_SCOPE_AGENT); }
__device__ __forceinline__ unsigned xb_add(unsigned* p, unsigned v) { return __hip_atomic_fetch_add(p, v, __ATOMIC_RELAXED, __HIP_MEMORY_SCOPE_AGENT); }
__device__ __forceinline__ unsigned xb_xcc_id() { return (unsigned)__builtin_amdgcn_s_getreg((3 << 11) | 20) & 0xFu; }
#define XB_SPIN(cond, bar) do { unsigned _sp = 0; while (cond) { __builtin_amdgcn_s_sleep(1); \
    if ((++_sp & 255u) == 0u) { if (xb_ld(&(bar)[XB_TMO])) break; if (_sp > XB_SPIN_CAP) { atomicAdd(&(bar)[XB_TMO], 1u); break; } } } } while (0)
struct XcdBarrier { unsigned* bar; unsigned x; volatile LAS unsigned* st; };
__device__ __forceinline__ XcdBarrier xcd_barrier_post(unsigned* bar, volatile LAS unsigned* st) {
    XcdBarrier b; b.bar = bar; b.x = xb_xcc_id(); b.st = st;
    if (threadIdx.x == 0) (void)xb_add(&bar[XB_XCNT(b.x)], 1u);
    return b;
}
__device__ __forceinline__ void xcd_barrier_complete(unsigned* bar, unsigned x, unsigned& nloc, unsigned& nx) {
    const unsigned G = gridDim.x * gridDim.y * gridDim.z;
    unsigned sum, cnt, mine, sp = 0u;
    for (;;) {
        sum = 0u; cnt = 0u; mine = 0u;
#pragma unroll
        for (unsigned j = 0; j < 16; ++j) { const unsigned c = xb_ld(&bar[XB_XCNT(j)]); sum += c; cnt += (c > 0u) ? 1u : 0u; mine = (j == x) ? c : mine; }
        if (sum == G) break;
        __builtin_amdgcn_s_sleep(1);
        if ((++sp & 255u) == 0u) { if (xb_ld(&bar[XB_TMO])) break; if (sp > XB_SPIN_CAP) { atomicAdd(&bar[XB_TMO], 1u); break; } }
    }
    nloc = mine > 0u ? mine : 1u; nx = cnt > 0u ? cnt : 1u;
}
__device__ __forceinline__ void xcd_barrier(const XcdBarrier& b) {
    asm volatile("s_waitcnt vmcnt(0)" ::: "memory");
    __syncthreads();
    if (threadIdx.x == 0) {
        unsigned* bar = b.bar;
        __builtin_amdgcn_s_waitcnt(0);
        unsigned nloc = b.st[0], nx = b.st[1];
        if (nloc == 0u) { xcd_barrier_complete(bar, b.x, nloc, nx); b.st[0] = nloc; b.st[1] = nx; }
        const unsigned old = xb_add(&bar[XB_XSUB(b.x)], 1u);
        const unsigned gen = old / nloc;
        if (old + 1u == (gen + 1u) * nloc) {
            __builtin_amdgcn_fence(__ATOMIC_RELEASE, "agent");
            asm volatile("s_waitcnt vmcnt(0)" ::: "memory");
            const unsigned og = xb_add(&bar[XB_TOP], 1u);
            const unsigned tg = og / nx;
            if (og + 1u == (tg + 1u) * nx) xb_add(&bar[XB_TOPGEN], 1u);
            else XB_SPIN(xb_ld(&bar[XB_TOPGEN]) == tg, bar);
            __builtin_amdgcn_fence(__ATOMIC_ACQUIRE, "agent");
            xb_add(&bar[XB_XGEN(b.x)], 1u);
            asm volatile("s_waitcnt vmcnt(0)" ::: "memory");
        } else {
            XB_SPIN(xb_ld(&bar[XB_XGEN(b.x)]) == gen, bar);
            __builtin_amdgcn_fence(__ATOMIC_ACQUIRE, "agent");
            asm volatile("s_waitcnt vmcnt(0)" ::: "memory");
        }
    }
    __syncthreads();
}

__global__ void __launch_bounds__(NTH, 2) mk_fwd(Args a) {
    extern __shared__ __attribute__((aligned(16))) unsigned char lds_raw[];
    LAS unsigned char* lds = (LAS unsigned char*)lds_raw;
    unsigned char* ws = a.ws;
    bf16_t* PG = (bf16_t*)a.out;
    const int lo = a.ph_lo, hi = a.ph_hi;
#ifndef PHASE_MASK
#define PHASE_MASK 0x7ff
#endif
#define IN(k) (((PHASE_MASK >> (k)) & 1) && lo <= (k) && (k) < hi)
#define SYNC(k) do { if (IN(k) && IN((k) + 1)) xcd_barrier(xb); } while (0)
    volatile LAS unsigned* xst = (volatile LAS unsigned*)(lds + LDS_BYTES - 1024);
    if (threadIdx.x < 2) xst[threadIdx.x] = 0u;
    __syncthreads();
    XcdBarrier xb; xb.bar = (unsigned*)(ws + WS_CTL); xb.x = 0; xb.st = xst;
    if (hi - lo > 1) xb = xcd_barrier_post((unsigned*)(ws + WS_CTL), xst);
    if (IN(0)) { phase0(a, lds); } SYNC(0);
    if (IN(1)) {
        { GemmDesc g{(const bf16_t*)(ws + WS_H0), D, (const bf16_t*)(ws + WS_WIN_T), D, M, 4096, D, 0};
          EpiGen E{(bf16_t*)(ws + WS_PAZ), 4096, nullptr, NO_SPLIT, nullptr, nullptr, 0, nullptr, 0, 0.f, nullptr, nullptr, 0, nullptr, nullptr, nullptr, nullptr};
          run_gemm(lds, g, E); }
        { GemmDesc g{(const bf16_t*)(ws + WS_H0_8), D / 2, (const bf16_t*)(ws + WS_WIN8), D / 2, M, 4096, D / 2, 0};
          EpiGen E{nullptr, 4096, PG, 0, nullptr, nullptr, 0, nullptr, 0, 0.f, nullptr, nullptr, 0, nullptr, nullptr, nullptr, nullptr};
          pg8::gemm_phase<true>(lds, g, E); }
        meta_proj(a);
    } SYNC(1);
    if (IN(2)) { phase2(a); }
    do { if (IN(2) && IN(4)) xcd_barrier(xb); } while (0);
    if (IN(4)) { ln1_fold_vectors(a); }
    if (IN(4)) {
        GemmDesc g{(const bf16_t*)(ws + WS_A2), 2048, (const bf16_t*)(ws + WS_W2_T), 2048, M, 2048, 2048, 0};
        EpiGen E{(bf16_t*)(ws + WS_PAZ), 2048, nullptr, NO_SPLIT, nullptr, PG + 2048, 4096, nullptr, 0, 0.f, PG, PG + 2048, 4096, nullptr, nullptr, nullptr, nullptr};
        run_gemm(lds, g, E);
    } SYNC(4);
    if (IN(5)) {
        GemmDesc g{(const bf16_t*)(ws + WS_PAZ), 2048, (const bf16_t*)(ws + WS_WO_T), 2048, M, 2048, 2048, 0};
        EpiGen E{(bf16_t*)(ws + WS_A2), 2048, nullptr, NO_SPLIT, nullptr, nullptr, 0, (const bf16_t*)(ws + WS_H0), 2048, ALPHA, nullptr, nullptr, 0, (unsigned long long*)(ws + WS_STATS), nullptr, nullptr, nullptr};
        run_gemm(lds, g, E);
    }
    do { if (IN(5) && IN(7)) xcd_barrier(xb); } while (0);
    if (IN(7)) {
        GemmDesc g{(const bf16_t*)(ws + WS_A2), 2048, (const bf16_t*)(ws + WS_WQ_T), 2048, M, 2048, 2048, 0};
        EpiGen E{(bf16_t*)(ws + WS_PAZ + 64 * MiB), 2048, nullptr, NO_SPLIT, nullptr, nullptr, 0, nullptr, 0, 0.f, nullptr, nullptr, 0, nullptr, (const long long*)(ws + WS_STATS), (const float*)(ws + WS_CS), (const float*)(ws + WS_BW)};
        run_gemm(lds, g, E);
    } SYNC(7);
    if (IN(8)) { phase7(a, lds); } SYNC(8);
    if (IN(9)) { phase_u(a, lds); } SYNC(9);
    if (IN(10)) { phase_v(a, lds); }
#undef IN
#undef SYNC
}
constexpr int N_PHASES = 11;

extern "C" void kernel_launch(void* const* d_in, const int* in_sizes, int n_in, void* d_out, int out_size, void* d_ws, size_t ws_size, hipStream_t stream) {
    static int grid = 0;
    if (grid == 0) {
        if (n_in != 21 || out_size != M * D || ws_size < WS_END) { fprintf(stderr, "kernel_launch: unexpected problem shape (n_in %d out %d ws %zu)\n", n_in, out_size, ws_size); grid = -1; return; }
        int dev = 0, cus = 0, per_cu = 0;
        hipGetDevice(&dev); hipDeviceGetAttribute(&cus, hipDeviceAttributeMultiprocessorCount, dev);
        hipFuncSetAttribute((const void*)mk_fwd, hipFuncAttributeMaxDynamicSharedMemorySize, LDS_BYTES);
        hipOccupancyMaxActiveBlocksPerMultiprocessor(&per_cu, (const void*)mk_fwd, NTH, LDS_BYTES);
        if (per_cu < 1) { fprintf(stderr, "kernel_launch: occupancy query says %d blocks per CU: the grid barrier needs every workgroup resident; nothing launched\n", per_cu); grid = -1; return; }
        grid = cus * 1;
        (void)hipGetLastError();
    }
    if (grid < 0) return;
    Args a{};
    for (int i = 0; i < 21; ++i) a.in[i] = (const float*)d_in[i];
    a.out = (float*)d_out; a.ws = (unsigned char*)d_ws;
#if N_LAUNCH_MODE == 0
    for (int p = 0; p < N_PHASES; ++p) { a.ph_lo = p; a.ph_hi = p + 1; hipLaunchKernelGGL(mk_fwd, dim3(grid), dim3(NTH), LDS_BYTES, stream, a); }
#else
    a.ph_lo = 0; a.ph_hi = N_PHASES;
    if (hipMemsetAsync((char*)d_ws + WS_CTL, 0, XCD_BAR_WORDS * 4, stream) != hipSuccess) { fprintf(stderr, "kernel_launch: memset of barrier words failed\n"); return; }
    void* args[] = {&a};
    hipError_t e = hipLaunchCooperativeKernel((const void*)mk_fwd, dim3(grid), dim3(NTH), args, LDS_BYTES, stream);
    if (e != hipSuccess) fprintf(stderr, "cooperative launch failed: %s (grid %d)\n", hipGetErrorString(e), grid);
#endif
}
```

```cpp
#include <hip/hip_runtime.h>
#include <hip/hip_cooperative_groups.h>
#include <cstdio>
#include <cstdint>
namespace cg = cooperative_groups;

#ifndef N_LAUNCH_MODE
#define N_LAUNCH_MODE 1
#endif
#ifndef USE_PG8
#define USE_PG8 1
#endif

#define LAS __attribute__((address_space(3)))
typedef unsigned short bf16_t;
typedef short bf16x8 __attribute__((ext_vector_type(8)));
typedef float f32x4 __attribute__((ext_vector_type(4)));
typedef float f32x16 __attribute__((ext_vector_type(16)));
typedef unsigned u32x4 __attribute__((ext_vector_type(4)));
typedef unsigned u32x2 __attribute__((ext_vector_type(2)));

constexpr int D = 2048, M = 16384, SEQ = 8192, NMETA = 16;
constexpr int NTH = 512, NWAVE = 8;
constexpr float ALPHA = 1.189207115002721f;
constexpr float LN_EPS = 1e-5f;
constexpr float STAT_FX = 16384.0f;
constexpr int LDS_BYTES = 8 * 20304 + 1024;

constexpr size_t MiB = 1024 * 1024;
constexpr size_t WS_CTL   = 0;
constexpr size_t WS_HM    = 64 * 1024;
constexpr size_t WS_PMETA = WS_HM + 64 * 1024;
constexpr size_t WS_KEYS  = WS_PMETA + 192 * 1024;
constexpr size_t WS_PW_T  = WS_KEYS + 512 * 1024;
constexpr size_t WS_WIN_T = 2 * MiB;
constexpr size_t WS_W2_T  = WS_WIN_T + 32 * MiB;
constexpr size_t WS_WO_T  = WS_W2_T + 8 * MiB;
constexpr size_t WS_WQ_T  = WS_WO_T + 8 * MiB;
constexpr size_t WS_EU    = WS_WQ_T + 8 * MiB;
constexpr size_t WS_EV    = WS_EU + 64 * MiB;
constexpr size_t WS_H0    = WS_EV + 64 * MiB;
constexpr size_t WS_PAZ   = WS_H0 + 64 * MiB;
constexpr size_t WS_POOLED= WS_PAZ + 128 * MiB;
constexpr size_t WS_A2    = WS_POOLED + 32 * MiB;
constexpr size_t WS_END   = WS_A2 + 64 * MiB;
constexpr size_t WS_CS = WS_CTL + 16384, WS_BW = WS_CTL + 24576;
constexpr size_t WS_STATS = WS_PW_T;
constexpr size_t WS_H0_8 = WS_EU + 20 * MiB;
constexpr size_t WS_WIN8 = WS_EV + 20 * MiB;
constexpr size_t WS_SA = WS_EU + 17 * MiB;
constexpr size_t WS_LNP = WS_EU + 18 * MiB;
constexpr size_t WS_CAMAX = WS_CTL + 32768;
constexpr size_t EXP_SC_OFF = 16 * MiB;

__device__ __forceinline__ unsigned f2bf(float f) { unsigned u = __float_as_uint(f); return (u + 0x7fffu + ((u >> 16) & 1u)) >> 16; }
typedef float f32x2_ __attribute__((ext_vector_type(2)));
typedef __bf16 bf16x2_ __attribute__((ext_vector_type(2)));
__device__ __forceinline__ unsigned pk2(float lo, float hi) { const f32x2_ v = {lo, hi}; return __builtin_bit_cast(unsigned, __builtin_convertvector(v, bf16x2_)); }
__device__ __forceinline__ unsigned pack_i8x4(float x0, float x1, float x2, float x3) {
    unsigned u = 0u;
    u = __builtin_amdgcn_cvt_pk_u8_f32(__builtin_rintf(x0) + 128.0f, 0, u); u = __builtin_amdgcn_cvt_pk_u8_f32(__builtin_rintf(x1) + 128.0f, 1, u);
    u = __builtin_amdgcn_cvt_pk_u8_f32(__builtin_rintf(x2) + 128.0f, 2, u); u = __builtin_amdgcn_cvt_pk_u8_f32(__builtin_rintf(x3) + 128.0f, 3, u);
    return u ^ 0x80808080u;
}
__device__ __forceinline__ float wave_max(float v) {
#pragma unroll
    for (int o = 1; o < 64; o <<= 1) v = fmaxf(v, __shfl_xor(v, o));
    return v;
}
__device__ __forceinline__ float bflo(unsigned u) { return __uint_as_float(u << 16); }
__device__ __forceinline__ float bfhi(unsigned u) { return __uint_as_float(u & 0xffff0000u); }
__device__ __forceinline__ float bf1(bf16_t b) { return __uint_as_float(((unsigned)b) << 16); }
__device__ __forceinline__ float wave_sum(float v) {
#pragma unroll
    for (int o = 1; o < 64; o <<= 1) v += __shfl_xor(v, o);
    return v;
}
__device__ __forceinline__ float ub_(unsigned w, int k) { return (float)((w >> (8 * k)) & 0xffu); }
__device__ __forceinline__ float sigmoidf_(float x) { return __builtin_amdgcn_rcpf(1.0f + __expf(-x)); }
__device__ __forceinline__ float gelu_erf(float x) { return 0.5f * x * (1.0f + erff(x * 0.70710678118654752f)); }
__device__ __forceinline__ unsigned ord_f32(float f) { unsigned u = __float_as_uint(f); return u ^ ((u >> 31) ? 0xffffffffu : 0x80000000u); }
__device__ __forceinline__ float unord_f32(unsigned u) { return __uint_as_float(u ^ ((u >> 31) ? 0x80000000u : 0xffffffffu)); }

struct Args {
    const float* in[21];
    float* out;
    unsigned char* ws;
    int ph_lo, ph_hi;
};

constexpr int NO_SPLIT = 1 << 30;
struct EpiGen {
    bf16_t* out; int ldo;
    bf16_t* out2; int split;
    const float* colscale;
    const bf16_t* mul; int ldm;
    const bf16_t* add; int lda_; float add_scale;
    const unsigned char* mid_num; const unsigned char* mid_den; int ld_mid;
    unsigned long long* stats_out;
    const long long* ln_stats; const float* ln_cs; const float* ln_bw;
    const float* rowscale;
    __device__ __forceinline__ void elem(int row, int col, float acc) const {
        if (col >= split) { out2[(size_t)row * ldo + (col - split)] = (bf16_t)f2bf(sigmoidf_(acc)); return; }
        float v = acc;
        if (colscale) v *= colscale[col];
        if (mul) v *= fmaxf(bf1(mul[(size_t)row * ldm + col]), 1e-30f);
        if (add) v += add_scale * bf1(add[(size_t)row * lda_ + col]);
        out[(size_t)row * ldo + col] = (bf16_t)f2bf(v);
    }
    __device__ __forceinline__ void mid8_apply(const u32x2 gn, const u32x2 gd, f32x4& v0, f32x4& v1) const {
        v0[0] *= ub_(gn.x, 0) * __builtin_amdgcn_rcpf(fmaxf(ub_(gd.x, 0), 1e-30f)); v0[1] *= ub_(gn.x, 1) * __builtin_amdgcn_rcpf(fmaxf(ub_(gd.x, 1), 1e-30f));
        v0[2] *= ub_(gn.x, 2) * __builtin_amdgcn_rcpf(fmaxf(ub_(gd.x, 2), 1e-30f)); v0[3] *= ub_(gn.x, 3) * __builtin_amdgcn_rcpf(fmaxf(ub_(gd.x, 3), 1e-30f));
        v1[0] *= ub_(gn.y, 0) * __builtin_amdgcn_rcpf(fmaxf(ub_(gd.y, 0), 1e-30f)); v1[1] *= ub_(gn.y, 1) * __builtin_amdgcn_rcpf(fmaxf(ub_(gd.y, 1), 1e-30f));
        v1[2] *= ub_(gn.y, 2) * __builtin_amdgcn_rcpf(fmaxf(ub_(gd.y, 2), 1e-30f)); v1[3] *= ub_(gn.y, 3) * __builtin_amdgcn_rcpf(fmaxf(ub_(gd.y, 3), 1e-30f));
    }
    __device__ __forceinline__ void vec8(int row, int col, f32x4 v0, f32x4 v1, float& rs, float& rq) const {
        if (rowscale) { const float rsc = rowscale[row]; v0 *= *(const f32x4*)(colscale + col) * rsc; v1 *= *(const f32x4*)(colscale + col + 4) * rsc; }
        if (col >= split) {
            u32x4 w; w.x = pk2(sigmoidf_(v0[0]), sigmoidf_(v0[1])); w.y = pk2(sigmoidf_(v0[2]), sigmoidf_(v0[3]));
            w.z = pk2(sigmoidf_(v1[0]), sigmoidf_(v1[1])); w.w = pk2(sigmoidf_(v1[2]), sigmoidf_(v1[3]));
            __builtin_nontemporal_store(w, (u32x4*)(out2 + (size_t)row * ldo + (col - split))); return;
        }
        if (ln_stats) { const float sm = (float)ln_stats[2 * row] * (1.0f / STAT_FX), sq = (float)ln_stats[2 * row + 1] * (1.0f / STAT_FX);
            const float mean = sm * (1.0f / D), rstd = rsqrtf(fmaxf(sq * (1.0f / D) - mean * mean, 0.f) + LN_EPS);
            const f32x4 c0 = *(const f32x4*)(ln_cs + col), c1 = *(const f32x4*)(ln_cs + col + 4), b0 = *(const f32x4*)(ln_bw + col), b1 = *(const f32x4*)(ln_bw + col + 4);
            v0 = (v0 - mean * c0) * rstd + b0; v1 = (v1 - mean * c1) * rstd + b1; }
        if (colscale && !rowscale) { const f32x4 s0 = *(const f32x4*)(colscale + col), s1 = *(const f32x4*)(colscale + col + 4); v0 *= s0; v1 *= s1; }
        if (mul) { const u32x4 g = __builtin_nontemporal_load((const u32x4*)(mul + (size_t)row * ldm + col));
            v0[0] *= fmaxf(bflo(g.x), 1e-30f); v0[1] *= fmaxf(bfhi(g.x), 1e-30f); v0[2] *= fmaxf(bflo(g.y), 1e-30f); v0[3] *= fmaxf(bfhi(g.y), 1e-30f);
            v1[0] *= fmaxf(bflo(g.z), 1e-30f); v1[1] *= fmaxf(bfhi(g.z), 1e-30f); v1[2] *= fmaxf(bflo(g.w), 1e-30f); v1[3] *= fmaxf(bfhi(g.w), 1e-30f); }
        if (add) { const u32x4 g = __builtin_nontemporal_load((const u32x4*)(add + (size_t)row * lda_ + col));
            v0[0] += add_scale * bflo(g.x); v0[1] += add_scale * bfhi(g.x); v0[2] += add_scale * bflo(g.y); v0[3] += add_scale * bfhi(g.y);
            v1[0] += add_scale * bflo(g.z); v1[1] += add_scale * bfhi(g.z); v1[2] += add_scale * bflo(g.w); v1[3] += add_scale * bfhi(g.w); }
        u32x4 w; w.x = pk2(v0[0], v0[1]); w.y = pk2(v0[2], v0[3]); w.z = pk2(v1[0], v1[1]); w.w = pk2(v1[2], v1[3]);
        *(u32x4*)(out + (size_t)row * ldo + col) = w;
        if (stats_out) { const float r0 = bflo(w.x), r1 = bfhi(w.x), r2 = bflo(w.y), r3 = bfhi(w.y), r4 = bflo(w.z), r5 = bfhi(w.z), r6 = bflo(w.w), r7 = bfhi(w.w);
            rs += ((r0 + r1) + (r2 + r3)) + ((r4 + r5) + (r6 + r7)); rq += ((r0 * r0 + r1 * r1) + (r2 * r2 + r3 * r3)) + ((r4 * r4 + r5 * r5) + (r6 * r6 + r7 * r7)); }
    }
    __device__ __forceinline__ void vec8x(int row, int col, f32x4 v0, f32x4 v1, float& rs, float& rq, const u32x4 g, const bool gate_unit, const float mean, const float rstd, const f32x4 c0, const f32x4 c1, const f32x4 b0, const f32x4 b1) const {
        if (gate_unit) {
            u32x2 w; w.x = 0u; w.y = 0u;
            w.x = __builtin_amdgcn_cvt_pk_u8_f32(__builtin_rintf(255.0f * sigmoidf_(v0[0])), 0, w.x); w.x = __builtin_amdgcn_cvt_pk_u8_f32(__builtin_rintf(255.0f * sigmoidf_(v0[1])), 1, w.x);
            w.x = __builtin_amdgcn_cvt_pk_u8_f32(__builtin_rintf(255.0f * sigmoidf_(v0[2])), 2, w.x); w.x = __builtin_amdgcn_cvt_pk_u8_f32(__builtin_rintf(255.0f * sigmoidf_(v0[3])), 3, w.x);
            w.y = __builtin_amdgcn_cvt_pk_u8_f32(__builtin_rintf(255.0f * sigmoidf_(v1[0])), 0, w.y); w.y = __builtin_amdgcn_cvt_pk_u8_f32(__builtin_rintf(255.0f * sigmoidf_(v1[1])), 1, w.y);
            w.y = __builtin_amdgcn_cvt_pk_u8_f32(__builtin_rintf(255.0f * sigmoidf_(v1[2])), 2, w.y); w.y = __builtin_amdgcn_cvt_pk_u8_f32(__builtin_rintf(255.0f * sigmoidf_(v1[3])), 3, w.y);
            __builtin_nontemporal_store(w, (u32x2*)((unsigned char*)out2 + (size_t)row * ldo + (col - split))); return;
        }
        if (ln_stats) { v0 = (v0 - mean * c0) * rstd + b0; v1 = (v1 - mean * c1) * rstd + b1; }
        if (colscale && !rowscale) { const f32x4 s0 = *(const f32x4*)(colscale + col), s1 = *(const f32x4*)(colscale + col + 4); v0 *= s0; v1 *= s1; }
        if (mul) {
            v0[0] *= fmaxf(bflo(g.x), 1e-30f); v0[1] *= fmaxf(bfhi(g.x), 1e-30f); v0[2] *= fmaxf(bflo(g.y), 1e-30f); v0[3] *= fmaxf(bfhi(g.y), 1e-30f);
            v1[0] *= fmaxf(bflo(g.z), 1e-30f); v1[1] *= fmaxf(bfhi(g.z), 1e-30f); v1[2] *= fmaxf(bflo(g.w), 1e-30f); v1[3] *= fmaxf(bfhi(g.w), 1e-30f); }
        if (add) {
            v0[0] += add_scale * bflo(g.x); v0[1] += add_scale * bfhi(g.x); v0[2] += add_scale * bflo(g.y); v0[3] += add_scale * bfhi(g.y);
            v1[0] += add_scale * bflo(g.z); v1[1] += add_scale * bfhi(g.z); v1[2] += add_scale * bflo(g.w); v1[3] += add_scale * bfhi(g.w); }
        u32x4 w; w.x = pk2(v0[0], v0[1]); w.y = pk2(v0[2], v0[3]); w.z = pk2(v1[0], v1[1]); w.w = pk2(v1[2], v1[3]);
        *(u32x4*)(out + (size_t)row * ldo + col) = w;
        if (stats_out) { const float r0 = bflo(w.x), r1 = bfhi(w.x), r2 = bflo(w.y), r3 = bfhi(w.y), r4 = bflo(w.z), r5 = bfhi(w.z), r6 = bflo(w.w), r7 = bfhi(w.w);
            rs += ((r0 + r1) + (r2 + r3)) + ((r4 + r5) + (r6 + r7)); rq += ((r0 * r0 + r1 * r1) + (r2 * r2 + r3 * r3)) + ((r4 * r4 + r5 * r5) + (r6 * r6 + r7 * r7)); }
    }
};

struct GemmDesc { const bf16_t* A; int lda; const bf16_t* Bt; int ldb; int Mr, Nc, K; int a_pn_cols; };

__device__ __forceinline__ void naive_gemm(LAS unsigned char* lds_, const GemmDesc g, const EpiGen& E) {
    LAS float* As = (LAS float*)lds_; LAS float* Bs = As + 64 * 33;
    const int tid = threadIdx.x, ty = tid >> 4, tx = tid & 15;
    const int ntn = g.Nc / 64, ntiles = (g.Mr / 64) * ntn;
    for (int tile = blockIdx.x; tile < ntiles; tile += gridDim.x) {
        const int tm = tile / ntn, tn = tile % ntn;
        const bf16_t* Ab = g.A + (size_t)(tm * 64) * g.lda + (size_t)((tn * 64) / 256) * g.a_pn_cols;
        const bf16_t* Bb = g.Bt + (size_t)(tn * 64) * g.ldb;
        float acc[2][4];
#pragma unroll
        for (int i = 0; i < 2; ++i)
#pragma unroll
            for (int j = 0; j < 4; ++j) acc[i][j] = 0.f;
        const int lr = tid >> 3, lc = (tid & 7) * 4;
        for (int k0 = 0; k0 < g.K; k0 += 32) {
            const u32x2 va = *(const u32x2*)(Ab + (size_t)lr * g.lda + k0 + lc);
            const u32x2 vb = *(const u32x2*)(Bb + (size_t)lr * g.ldb + k0 + lc);
            As[lr * 33 + lc + 0] = bflo(va.x); As[lr * 33 + lc + 1] = bfhi(va.x); As[lr * 33 + lc + 2] = bflo(va.y); As[lr * 33 + lc + 3] = bfhi(va.y);
            Bs[lr * 33 + lc + 0] = bflo(vb.x); Bs[lr * 33 + lc + 1] = bfhi(vb.x); Bs[lr * 33 + lc + 2] = bflo(vb.y); Bs[lr * 33 + lc + 3] = bfhi(vb.y);
            __syncthreads();
#pragma unroll 8
            for (int k = 0; k < 32; ++k) {
                const float a0 = As[ty * 33 + k], a1 = As[(ty + 32) * 33 + k];
                const float b0 = Bs[tx * 33 + k], b1 = Bs[(tx + 16) * 33 + k], b2 = Bs[(tx + 32) * 33 + k], b3 = Bs[(tx + 48) * 33 + k];
                acc[0][0] += a0 * b0; acc[0][1] += a0 * b1; acc[0][2] += a0 * b2; acc[0][3] += a0 * b3;
                acc[1][0] += a1 * b0; acc[1][1] += a1 * b1; acc[1][2] += a1 * b2; acc[1][3] += a1 * b3;
            }
            __syncthreads();
        }
#pragma unroll
        for (int i = 0; i < 2; ++i)
#pragma unroll
            for (int j = 0; j < 4; ++j) E.elem(tm * 64 + ty + 32 * i, tn * 64 + tx + 16 * j, acc[i][j]);
    }
}

namespace pg8 {
constexpr int BM = 256, BK = 64, HALF = 128, HTB = HALF * BK * 2, STAGE_BYTES = 8 * HTB, NXCD = 8, WGM = 4;
__device__ __forceinline__ int lds_byte(int r, int c) { const int st = (r >> 4) * 2 + (c >> 5), rr = r & 15, cc = c & 31, ob = rr * 64 + cc * 2; return st * 1024 + (ob ^ (((ob >> 9) & 1) << 5)); }
__device__ __forceinline__ void stage_rc(int b, int& R, int& C) { const int st = b / 1024, sb = b % 1024, swz = sb ^ (((sb >> 9) & 1) << 5); R = (st >> 1) * 16 + swz / 64; C = (st & 1) * 32 + (swz % 64) / 2; }
__device__ __forceinline__ int perm32(int rho) { const int n = rho >> 4, i = rho & 15; return 8 * (i >> 2) + 4 * n + (i & 3); }
struct Unit { int pm, pn; };
struct StaticOrder {
    int nM, nN, nwg, G, c;
    __device__ void init(int Mr, int Nc, int G_, int c_) { nM = Mr / BM; nN = Nc / BM; nwg = nM * nN; G = G_; c = c_; }
    __device__ bool next(int i, Unit& u) const {
        const long L = (long)i * G + c; if (L >= nwg) return false;
        int wgid = (int)L; { const int q = nwg / NXCD, r = nwg % NXCD, xcd = wgid % NXCD, off = wgid / NXCD; wgid = (xcd < r ? xcd * (q + 1) : r * (q + 1) + (xcd - r) * q) + off; }
        const int nig = WGM * nN, gid = wgid / nig, fm = gid * WGM, gsz = (nM - fm) < WGM ? (nM - fm) : WGM;
        u.pm = fm + ((wgid % nig) % gsz); u.pn = (wgid % nig) / gsz; return true;
    }
};
__device__ __forceinline__ void epilogue(const EpiGen& E, const f32x4 (&acc)[2][2][4][2], const Unit& u, int wr, int wc, int fr, int fq, const u32x2 (&gk)[2][4][2]) {
    const int row0 = u.pm * BM + wr * 64 + fr, col0 = u.pn * BM + wc * 32 + 8 * fq;
    f32x4 csc[2][2];
    const bool gate_unit = u.pn * BM >= E.split;
    f32x4 fc[2][2], fb[2][2];
#pragma unroll
    for (int bj = 0; bj < 2; ++bj) { fc[bj][0] = (f32x4){0.f, 0.f, 0.f, 0.f}; fc[bj][1] = fc[bj][0]; fb[bj][0] = fc[bj][0]; fb[bj][1] = fc[bj][0];
        if (E.ln_stats) { const int col = col0 + bj * HALF; fc[bj][0] = *(const f32x4*)(E.ln_cs + col); fc[bj][1] = *(const f32x4*)(E.ln_cs + col + 4); fb[bj][0] = *(const f32x4*)(E.ln_bw + col); fb[bj][1] = *(const f32x4*)(E.ln_bw + col + 4); } }
#pragma unroll
    for (int bj = 0; bj < 2; ++bj) { csc[bj][0] = (f32x4){1.f, 1.f, 1.f, 1.f}; csc[bj][1] = csc[bj][0];
        if (E.rowscale) { csc[bj][0] = *(const f32x4*)(E.colscale + col0 + bj * HALF); csc[bj][1] = *(const f32x4*)(E.colscale + col0 + bj * HALF + 4); } }
#pragma unroll
    for (int ai = 0; ai < 2; ++ai) {
        u32x4 pre[4][2]; float rsc[4]; long long ssum[4], ssq[4];
#pragma unroll
        for (int m = 0; m < 4; ++m) { const int row = row0 + ai * HALF + m * 16; rsc[m] = 1.f; if (E.rowscale) rsc[m] = E.rowscale[row];
            ssum[m] = 0; ssq[m] = 0; if (E.ln_stats) { ssum[m] = E.ln_stats[2 * row]; ssq[m] = E.ln_stats[2 * row + 1]; }
#pragma unroll
            for (int bj = 0; bj < 2; ++bj) { const int col = col0 + bj * HALF; pre[m][bj] = (u32x4){0u, 0u, 0u, 0u};
                if (E.mul) pre[m][bj] = __builtin_nontemporal_load((const u32x4*)(E.mul + (size_t)row * E.ldm + col));
                else if (E.add) pre[m][bj] = __builtin_nontemporal_load((const u32x4*)(E.add + (size_t)row * E.lda_ + col)); } }
#pragma unroll
        for (int m = 0; m < 4; ++m) {
            float rs = 0.f, rq = 0.f; const int row = row0 + ai * HALF + m * 16;
            const float sm = (float)ssum[m] * (1.0f / STAT_FX), sq = (float)ssq[m] * (1.0f / STAT_FX);
            const float mean = sm * (1.0f / D), rstd = rsqrtf(fmaxf(sq * (1.0f / D) - mean * mean, 0.f) + LN_EPS);
#pragma unroll
            for (int bj = 0; bj < 2; ++bj) { f32x4 v0 = acc[ai][bj][m][0], v1 = acc[ai][bj][m][1];
                if (E.rowscale) { v0 *= csc[bj][0] * rsc[m]; v1 *= csc[bj][1] * rsc[m]; }
                if (E.mid_num) { const u32x2 q = gk[ai][m][bj]; constexpr float k = 1.0f / 255.0f;
                    v0[0] *= fmaxf(ub_(q.x, 0), 1e-30f) * k; v0[1] *= fmaxf(ub_(q.x, 1), 1e-30f) * k; v0[2] *= fmaxf(ub_(q.x, 2), 1e-30f) * k; v0[3] *= fmaxf(ub_(q.x, 3), 1e-30f) * k;
                    v1[0] *= fmaxf(ub_(q.y, 0), 1e-30f) * k; v1[1] *= fmaxf(ub_(q.y, 1), 1e-30f) * k; v1[2] *= fmaxf(ub_(q.y, 2), 1e-30f) * k; v1[3] *= fmaxf(ub_(q.y, 3), 1e-30f) * k; }
                E.vec8x(row, col0 + bj * HALF, v0, v1, rs, rq, pre[m][bj], gate_unit, mean, rstd, fc[bj][0], fc[bj][1], fb[bj][0], fb[bj][1]); }
            if (E.stats_out) {
                rs += __shfl_xor(rs, 16); rs += __shfl_xor(rs, 32); rq += __shfl_xor(rq, 16); rq += __shfl_xor(rq, 32);
                if (fq == 0) { atomicAdd(E.stats_out + 2 * row, (unsigned long long)(long long)__float2int_rn(rs * STAT_FX)); atomicAdd(E.stats_out + 2 * row + 1, (unsigned long long)(long long)__float2int_rn(rq * STAT_FX)); }
            }
        }
    }
}
typedef int v8i __attribute__((ext_vector_type(8)));
typedef int v4i __attribute__((ext_vector_type(4)));
constexpr float FP8_W_UNSCALE = 0.015625f;
__device__ __forceinline__ v8i cat8(bf16x8 lo, bf16x8 hi) { const v4i a = __builtin_bit_cast(v4i, lo), b = __builtin_bit_cast(v4i, hi); v8i r; r[0] = a[0]; r[1] = a[1]; r[2] = a[2]; r[3] = a[3]; r[4] = b[0]; r[5] = b[1]; r[6] = b[2]; r[7] = b[3]; return r; }
__device__ __forceinline__ void mid_hook(const EpiGen& E, f32x4 (&acc)[2][2][4][2], const Unit& u, int wr, int wc, int fr_in, int fq_in, u32x2 (&gk)[2][4][2]) {
    int fr = fr_in, fq = fq_in;
    asm volatile("" : "+v"(fr), "+v"(fq));
    const int row0 = u.pm * BM + wr * 64 + fr, col0 = u.pn * BM + wc * 32 + 8 * fq;
#pragma unroll
    for (int ai = 0; ai < 2; ++ai) {
        u32x2 gn[4][2];
#pragma unroll
        for (int m = 0; m < 4; ++m)
#pragma unroll
            for (int bj = 0; bj < 2; ++bj) { const size_t o = (size_t)(row0 + ai * HALF + m * 16) * E.ld_mid + col0 + bj * HALF;
                gn[m][bj] = __builtin_nontemporal_load((const u32x2*)(E.mid_num + o)); gk[ai][m][bj] = __builtin_nontemporal_load((const u32x2*)(E.mid_den + o)); }
#pragma unroll
        for (int m = 0; m < 4; ++m)
#pragma unroll
            for (int bj = 0; bj < 2; ++bj) E.mid8_apply(gn[m][bj], gk[ai][m][bj], acc[ai][bj][m][0], acc[ai][bj][m][1]);
        asm volatile("" ::: "memory"); }
}
template <int MODE> __device__ __forceinline__ void gemm_phase(LAS unsigned char* lds, const GemmDesc g, const EpiGen& E) {
    const int tid = threadIdx.x, wid = __builtin_amdgcn_readfirstlane(tid >> 6), lane = tid & 63, wr = wid >> 2, wc = wid & 3, fr = lane & 15, fq = lane >> 4;
    const int K = g.K, nt = K / BK;
    StaticOrder S; S.init(g.Mr, g.Nc, (int)gridDim.x, (int)blockIdx.x);
    unsigned voffA[2], voffB[2];
#pragma unroll
    for (int i = 0; i < 2; ++i) { int R, C; stage_rc(tid * 16 + i * 8192, R, C); const int Rb = (R & ~31) + perm32(R & 31);
        voffA[i] = (unsigned)(R * g.lda + C) * 2u; voffB[i] = (unsigned)(Rb * g.ldb + C) * 2u; }
    const __amdgpu_buffer_rsrc_t rA = __builtin_amdgcn_make_buffer_rsrc((void*)g.A, 0, 0x7FFFFFFF, 0x00020000), rB = __builtin_amdgcn_make_buffer_rsrc((void*)g.Bt, 0, 0x7FFFFFFF, 0x00020000);
    const unsigned kstep = (unsigned)(BK * 2);
    const unsigned hstepA = (unsigned)HALF * g.lda * 2, hstepB = (unsigned)HALF * g.ldb * 2;
    const unsigned tstepA = 2 * hstepA, tstepB = 2 * hstepB;
    const unsigned pnA = (unsigned)g.a_pn_cols * 2;
    const unsigned ldsw = (unsigned)wid * 1024u;
    const int aoff = lds_byte(wr * 64 + fr, fq * 8), boff = lds_byte(wc * 32 + fr, fq * 8);
#define PG8_SA(b, h) (((b) * 2 + (h)) * HTB)
#define PG8_SB(b, h) ((4 + (b) * 2 + (h)) * HTB)
#define PG8_STAGE(bufoff, rs, soff, voff) do { _Pragma("unroll") for (int _i = 0; _i < 2; ++_i) \
        __builtin_amdgcn_raw_ptr_buffer_load_lds(rs, (LAS unsigned*)(lds + (bufoff) + ldsw + _i * 8192), 16, (int)(voff)[_i], (int)(soff), 0, 0); } while (0)
#define PG8_LDA(dst, b, h) do { _Pragma("unroll") for (int m = 0; m < 4; ++m) _Pragma("unroll") for (int k = 0; k < 2; ++k) dst[m][k] = *(const LAS bf16x8*)(lds + PG8_SA(b, h) + aoff + m * 2048 + k * 1024); } while (0)
#define PG8_LDB(dst, b, h) do { _Pragma("unroll") for (int n = 0; n < 2; ++n) _Pragma("unroll") for (int k = 0; k < 2; ++k) dst[n][k] = *(const LAS bf16x8*)(lds + PG8_SB(b, h) + boff + n * 2048 + k * 1024); } while (0)
#define PG8_MMA(ai, bj, At, Bt) do { __builtin_amdgcn_s_setprio(1); _Pragma("unroll") for (int m = 0; m < 4; ++m) _Pragma("unroll") for (int n = 0; n < 2; ++n) { \
        if constexpr (MODE == 2) { _Pragma("unroll") for (int k = 0; k < 2; ++k) acc[ai][bj][m][n] = __builtin_bit_cast(f32x4, __builtin_amdgcn_mfma_i32_16x16x64_i8(__builtin_bit_cast(v4i, Bt[n][k]), __builtin_bit_cast(v4i, At[m][k]), __builtin_bit_cast(v4i, acc[ai][bj][m][n]), 0, 0, 0)); } \
        else if constexpr (MODE == 1) { acc[ai][bj][m][n] = __builtin_amdgcn_mfma_scale_f32_16x16x128_f8f6f4(cat8(Bt[n][0], Bt[n][1]), cat8(At[m][0], At[m][1]), acc[ai][bj][m][n], 0, 0, 0, 0, 0, 0); } \
        else { _Pragma("unroll") for (int k = 0; k < 2; ++k) acc[ai][bj][m][n] = __builtin_amdgcn_mfma_f32_16x16x32_bf16(Bt[n][k], At[m][k], acc[ai][bj][m][n], 0, 0, 0); } } \
        __builtin_amdgcn_s_setprio(0); } while (0)
#define PG8_WAIT_V(n) asm volatile("s_waitcnt vmcnt(" #n ")" ::: "memory")
#define PG8_WAIT_L(n) asm volatile("s_waitcnt lgkmcnt(" #n ")" ::: "memory")
#define PG8_BAR __builtin_amdgcn_s_barrier()
#define PG8_SCHED __builtin_amdgcn_sched_barrier(0)
    Unit cur, nxt; int ui = 0;
    if (!S.next(0, cur)) return;
    f32x4 acc[2][2][4][2];
#pragma unroll
    for (int a = 0; a < 2; ++a)
#pragma unroll
        for (int b = 0; b < 2; ++b)
#pragma unroll
            for (int m = 0; m < 4; ++m)
#pragma unroll
                for (int n = 0; n < 2; ++n) acc[a][b][m][n] = (f32x4){0.f, 0.f, 0.f, 0.f};
    bf16x8 At[4][2], B0[2][2], B1[2][2];
    u32x2 gk[2][4][2];
#pragma unroll
    for (int a_ = 0; a_ < 2; ++a_)
#pragma unroll
        for (int m_ = 0; m_ < 4; ++m_) { gk[a_][m_][0] = (u32x2){0u, 0u}; gk[a_][m_][1] = (u32x2){0u, 0u}; }
    unsigned cA = (unsigned)cur.pm * tstepA + (unsigned)cur.pn * pnA, cB = (unsigned)cur.pn * tstepB;
    PG8_STAGE(PG8_SB(0, 0), rB, cB, voffB); PG8_STAGE(PG8_SA(0, 0), rA, cA, voffA); PG8_STAGE(PG8_SB(0, 1), rB, cB + hstepB, voffB); PG8_STAGE(PG8_SA(0, 1), rA, cA + hstepA, voffA);
    if (wr == 1) PG8_BAR;
    PG8_WAIT_V(4); PG8_BAR;
    PG8_STAGE(PG8_SB(1, 0), rB, cB + kstep, voffB); PG8_STAGE(PG8_SA(1, 0), rA, cA + kstep, voffA); PG8_STAGE(PG8_SB(1, 1), rB, cB + hstepB + kstep, voffB);
    PG8_WAIT_V(6); PG8_BAR;
    for (;;) {
        const bool has_next = S.next(ui + 1, nxt);
        const unsigned nA = has_next ? (unsigned)nxt.pm * tstepA + (unsigned)nxt.pn * pnA : cA, nB = has_next ? (unsigned)nxt.pn * tstepB : cB;
        for (int t = 0; t < nt; t += 2) {
            const bool last = (t == nt - 2);
            const unsigned a1 = cA + (unsigned)(t + 1) * kstep;
            const unsigned a2 = last ? nA : cA + (unsigned)(t + 2) * kstep, b2 = last ? nB : cB + (unsigned)(t + 2) * kstep;
            const unsigned a3 = a2 + kstep, b3 = b2 + kstep;
            if (E.mid_num != nullptr && t == (nt >> 1)) mid_hook(E, acc, cur, wr, wc, fr, fq, gk);
            PG8_LDB(B0, 0, 0); PG8_SCHED; PG8_LDA(At, 0, 0); PG8_STAGE(PG8_SA(1, 1), rA, a1 + hstepA, voffA);
            PG8_WAIT_L(8); PG8_BAR; PG8_WAIT_L(0); PG8_MMA(0, 0, At, B0); PG8_BAR; PG8_SCHED;
            PG8_LDB(B1, 0, 1); PG8_STAGE(PG8_SB(0, 0), rB, b2, voffB);
            PG8_BAR; PG8_WAIT_L(0); PG8_MMA(0, 1, At, B1); PG8_BAR;
            PG8_LDA(At, 0, 1); PG8_STAGE(PG8_SA(0, 0), rA, a2, voffA);
            PG8_BAR; PG8_WAIT_L(0); PG8_MMA(1, 0, At, B0); PG8_BAR; PG8_SCHED;
            PG8_STAGE(PG8_SB(0, 1), rB, b2 + hstepB, voffB);
            PG8_WAIT_V(6); PG8_BAR; PG8_MMA(1, 1, At, B1); PG8_BAR;
            PG8_LDB(B0, 1, 0); PG8_SCHED; PG8_LDA(At, 1, 0); PG8_STAGE(PG8_SA(0, 1), rA, a2 + hstepA, voffA);
            PG8_WAIT_L(8); PG8_BAR; PG8_WAIT_L(0); PG8_MMA(0, 0, At, B0); PG8_BAR; PG8_SCHED;
            PG8_LDB(B1, 1, 1); PG8_STAGE(PG8_SB(1, 0), rB, b3, voffB);
            PG8_BAR; PG8_WAIT_L(0); PG8_MMA(0, 1, At, B1); PG8_BAR;
            PG8_LDA(At, 1, 1); PG8_STAGE(PG8_SA(1, 0), rA, a3, voffA);
            PG8_BAR; PG8_WAIT_L(0); PG8_MMA(1, 0, At, B0); PG8_BAR; PG8_SCHED;
            PG8_STAGE(PG8_SB(1, 1), rB, b3 + hstepB, voffB);
            PG8_WAIT_V(6); PG8_BAR; PG8_MMA(1, 1, At, B1); PG8_BAR;
        }
        if constexpr (MODE == 1) {
#pragma unroll
            for (int a = 0; a < 2; ++a)
#pragma unroll
                for (int b = 0; b < 2; ++b)
#pragma unroll
                    for (int m = 0; m < 4; ++m)
#pragma unroll
                        for (int n = 0; n < 2; ++n) acc[a][b][m][n] *= FP8_W_UNSCALE; }
        if constexpr (MODE == 2) {
#pragma unroll
            for (int a = 0; a < 2; ++a)
#pragma unroll
                for (int b = 0; b < 2; ++b)
#pragma unroll
                    for (int m = 0; m < 4; ++m)
#pragma unroll
                        for (int n = 0; n < 2; ++n) { const v4i q = __builtin_bit_cast(v4i, acc[a][b][m][n]); acc[a][b][m][n] = (f32x4){(float)q[0], (float)q[1], (float)q[2], (float)q[3]}; } }
        epilogue(E, acc, cur, wr, wc, fr, fq, gk);
        if (!has_next) break;
#pragma unroll
        for (int a = 0; a < 2; ++a)
#pragma unroll
            for (int b = 0; b < 2; ++b)
#pragma unroll
                for (int m = 0; m < 4; ++m)
#pragma unroll
                    for (int n = 0; n < 2; ++n) acc[a][b][m][n] = (f32x4){0.f, 0.f, 0.f, 0.f};
        cur = nxt; cA = nA; cB = nB; ++ui;
    }
    PG8_WAIT_V(0);
    if (wr == 0) PG8_BAR;
    PG8_BAR;
#undef PG8_SA
#undef PG8_SB
#undef PG8_STAGE
#undef PG8_LDA
#undef PG8_LDB
#undef PG8_MMA
#undef PG8_WAIT_V
#undef PG8_WAIT_L
#undef PG8_BAR
#undef PG8_SCHED
}
}

__device__ __forceinline__ void run_gemm(LAS unsigned char* lds, const GemmDesc& g, const EpiGen& E) {
#if USE_PG8
    pg8::gemm_phase<0>(lds, g, E);
#else
    naive_gemm(lds, g, E);
    __syncthreads();
#endif
}

__device__ __forceinline__ void ln_row_f32_to_bf16(const float* xrow, const float* g, const float* b, bf16_t* orow, int lane) {
    const f32x4* xr = (const f32x4*)xrow + lane;
    f32x4 v[8]; float s = 0.f;
#pragma unroll
    for (int j = 0; j < 8; ++j) { v[j] = xr[64 * j]; s += (v[j][0] + v[j][1]) + (v[j][2] + v[j][3]); }
    const float mean = wave_sum(s) * (1.f / D); float s2 = 0.f;
#pragma unroll
    for (int j = 0; j < 8; ++j) { v[j] = v[j] - mean; s2 += (v[j][0] * v[j][0] + v[j][1] * v[j][1]) + (v[j][2] * v[j][2] + v[j][3] * v[j][3]); }
    const float rstd = rsqrtf(wave_sum(s2) * (1.f / D) + LN_EPS);
    u32x2* o8 = (u32x2*)orow + lane;
#pragma unroll
    for (int j = 0; j < 8; ++j) { const f32x4 gg = ((const f32x4*)g)[lane + 64 * j], bb = ((const f32x4*)b)[lane + 64 * j];
        const f32x4 y = v[j] * rstd * gg + bb; u32x2 w; w.x = pk2(y[0], y[1]); w.y = pk2(y[2], y[3]); o8[64 * j] = w; }
}
__device__ __forceinline__ void transpose_item(const float* W, int N, bf16_t* WT, int ldt, int koff, LAS float* scr, int item, int lane, const float* kscale = nullptr, unsigned* colmax = nullptr) {
    const int nblk = N / 32, kb = item / nblk, nb = item % nblk, k0 = 64 * kb, n0 = 32 * nb;
    float v[32];
#pragma unroll
    for (int i = 0; i < 32; ++i) { const int kk = 2 * i + (lane >> 5); v[i] = __builtin_nontemporal_load(W + (size_t)(k0 + kk) * N + n0 + (lane & 31)); }
#pragma unroll
    for (int i = 0; i < 32; ++i) { const int kk = 2 * i + (lane >> 5); const float ks = kscale ? kscale[k0 + kk] : 1.0f; scr[kk * 33 + (lane & 31)] = v[i] * ks; }
    if (colmax) { float mx = 0.f;
#pragma unroll
        for (int i = 0; i < 32; ++i) mx = fmaxf(mx, fabsf(v[i]));
        mx = fmaxf(mx, __shfl_xor(mx, 32)); if (lane < 32) atomicMax(colmax + n0 + lane, __float_as_uint(mx)); }
    asm volatile("s_waitcnt lgkmcnt(0)" ::: "memory");
    const int c = lane & 7;
#pragma unroll
    for (int j = 0; j < 4; ++j) { const int n = (lane >> 3) + 8 * j; const LAS float* s = scr + (8 * c) * 33 + n;
        u32x4 o; o.x = pk2(s[0 * 33], s[1 * 33]); o.y = pk2(s[2 * 33], s[3 * 33]); o.z = pk2(s[4 * 33], s[5 * 33]); o.w = pk2(s[6 * 33], s[7 * 33]);
        *(u32x4*)(WT + (size_t)(n0 + n) * ldt + koff + k0 + 8 * c) = o; }
    asm volatile("s_waitcnt lgkmcnt(0)" ::: "memory");
}
__device__ __forceinline__ void transpose_item_i8(const float* W, int N, unsigned char* WT8, const float* colmax, LAS float* scr, int item, int lane) {
    const int nblk = N / 32, kb = item / nblk, nb = item % nblk, k0 = 64 * kb, n0 = 32 * nb;
    float v[32];
#pragma unroll
    for (int i = 0; i < 32; ++i) { const int kk = 2 * i + (lane >> 5); v[i] = W[(size_t)(k0 + kk) * N + n0 + (lane & 31)]; }
    const float cm = colmax[n0 + (lane & 31)], inv = cm > 0.f ? 127.0f / cm : 0.f;
#pragma unroll
    for (int i = 0; i < 32; ++i) { const int kk = 2 * i + (lane >> 5); scr[kk * 33 + (lane & 31)] = v[i] * inv; }
    asm volatile("s_waitcnt lgkmcnt(0)" ::: "memory");
    const int c = lane & 7;
#pragma unroll
    for (int j = 0; j < 4; ++j) { const int n = (lane >> 3) + 8 * j; const LAS float* s = scr + (8 * c) * 33 + n;
        u32x2 o; o.x = pack_i8x4(s[0 * 33], s[1 * 33], s[2 * 33], s[3 * 33]); o.y = pack_i8x4(s[4 * 33], s[5 * 33], s[6 * 33], s[7 * 33]);
        *(u32x2*)(WT8 + (size_t)(n0 + n) * 2048 + k0 + 8 * c) = o; }
    asm volatile("s_waitcnt lgkmcnt(0)" ::: "memory");
}
__device__ __forceinline__ void cvt_flat(const float* src, bf16_t* dst, size_t n8, size_t gt, size_t ngt) {
    for (size_t i = gt; i < n8; i += ngt) { const f32x4 a = ((const f32x4*)src)[2 * i], b = ((const f32x4*)src)[2 * i + 1];
        u32x4 o; o.x = pk2(a[0], a[1]); o.y = pk2(a[2], a[3]); o.z = pk2(b[0], b[1]); o.w = pk2(b[2], b[3]); ((u32x4*)dst)[i] = o; }
}

__device__ __forceinline__ void ln_2rows(const float* xa, bf16_t* oa, unsigned* oa8, float* sa_out, const float* xb, bf16_t* ob, unsigned* ob8, float* sb_out, const float* g, const float* b, int lane) {
    const f32x4* pa = (const f32x4*)xa + lane; const f32x4* pb = (const f32x4*)xb + lane;
    f32x4 va[8], vb[8];
#pragma unroll
    for (int j = 0; j < 8; ++j) va[j] = __builtin_nontemporal_load(pa + 64 * j);
#pragma unroll
    for (int j = 0; j < 8; ++j) vb[j] = __builtin_nontemporal_load(pb + 64 * j);
    float sa = 0.f, sb = 0.f;
#pragma unroll
    for (int j = 0; j < 8; ++j) { sa += (va[j][0] + va[j][1]) + (va[j][2] + va[j][3]); sb += (vb[j][0] + vb[j][1]) + (vb[j][2] + vb[j][3]); }
#pragma unroll
    for (int o = 1; o < 64; o <<= 1) { sa += __shfl_xor(sa, o); sb += __shfl_xor(sb, o); }
    const float ma = sa * (1.f / D), mb = sb * (1.f / D); float qa = 0.f, qb = 0.f;
#pragma unroll
    for (int j = 0; j < 8; ++j) { va[j] = va[j] - ma; vb[j] = vb[j] - mb;
        qa += (va[j][0] * va[j][0] + va[j][1] * va[j][1]) + (va[j][2] * va[j][2] + va[j][3] * va[j][3]); qb += (vb[j][0] * vb[j][0] + vb[j][1] * vb[j][1]) + (vb[j][2] * vb[j][2] + vb[j][3] * vb[j][3]); }
#pragma unroll
    for (int o = 1; o < 64; o <<= 1) { qa += __shfl_xor(qa, o); qb += __shfl_xor(qb, o); }
    const float ra = rsqrtf(qa * (1.f / D) + LN_EPS), rb = rsqrtf(qb * (1.f / D) + LN_EPS);
    u32x2* o8a = (u32x2*)oa + lane; u32x2* o8b = (u32x2*)ob + lane;
    float xa_max = 0.f, xb_max = 0.f;
#pragma unroll
    for (int j = 0; j < 8; ++j) { const f32x4 gg = ((const f32x4*)g)[lane + 64 * j], bb = ((const f32x4*)b)[lane + 64 * j];
        const f32x4 ya = va[j] * ra * gg + bb, yb = vb[j] * rb * gg + bb; u32x2 w; w.x = pk2(ya[0], ya[1]); w.y = pk2(ya[2], ya[3]); o8a[64 * j] = w; w.x = pk2(yb[0], yb[1]); w.y = pk2(yb[2], yb[3]); o8b[64 * j] = w;
        va[j] = ya; vb[j] = yb;
        xa_max = fmaxf(fmaxf(xa_max, fmaxf(fabsf(ya[0]), fabsf(ya[1]))), fmaxf(fabsf(ya[2]), fabsf(ya[3]))); xb_max = fmaxf(fmaxf(xb_max, fmaxf(fabsf(yb[0]), fabsf(yb[1]))), fmaxf(fabsf(yb[2]), fabsf(yb[3]))); }
    if (oa8 || ob8) {
        xa_max = wave_max(xa_max); xb_max = wave_max(xb_max);
        const float ia = xa_max > 0.f ? 127.0f / xa_max : 0.f, ib = xb_max > 0.f ? 127.0f / xb_max : 0.f;
#pragma unroll
        for (int j = 0; j < 8; ++j) {
            if (oa8) oa8[lane + 64 * j] = pack_i8x4(va[j][0] * ia, va[j][1] * ia, va[j][2] * ia, va[j][3] * ia);
            if (ob8) ob8[lane + 64 * j] = pack_i8x4(vb[j][0] * ib, vb[j][1] * ib, vb[j][2] * ib, vb[j][3] * ib); }
        if (lane == 0) { if (oa8) *sa_out = xa_max * (1.0f / (127.0f * 127.0f)); if (ob8) *sb_out = xb_max * (1.0f / (127.0f * 127.0f)); }
    }
}
__device__ __forceinline__ void fp4_pack_row(const f32x4 (&v)[8], unsigned* drow, unsigned char* sc_out, int sidx, int lane) {
    float am = 0.f;
#pragma unroll
    for (int m = 0; m < 8; ++m) am = fmaxf(fmaxf(am, fmaxf(fabsf(v[m][0]), fabsf(v[m][1]))), fmaxf(fabsf(v[m][2]), fabsf(v[m][3])));
    unsigned sb = (__float_as_uint(am * (1.0f / 6.0f)) + 0x7FFFFFu) & 0x7F800000u;
    sb = sb < (40u << 23) ? (40u << 23) : sb;
    const float scale = __uint_as_float(sb);
    u32x4 w;
#pragma unroll
    for (int d = 0; d < 4; ++d) { unsigned x = 0;
        x = __builtin_amdgcn_cvt_scalef32_pk_fp4_f32(x, v[2 * d][0], v[2 * d][1], scale, 0); x = __builtin_amdgcn_cvt_scalef32_pk_fp4_f32(x, v[2 * d][2], v[2 * d][3], scale, 1);
        x = __builtin_amdgcn_cvt_scalef32_pk_fp4_f32(x, v[2 * d + 1][0], v[2 * d + 1][1], scale, 2); x = __builtin_amdgcn_cvt_scalef32_pk_fp4_f32(x, v[2 * d + 1][2], v[2 * d + 1][3], scale, 3);
        w[d] = x; }
    __builtin_nontemporal_store(w, (u32x4*)drow + lane);
    sc_out[sidx] = (unsigned char)(sb >> 23);
}
__device__ __forceinline__ void transpose_item_wq(const float* W, bf16_t* WT, LAS float* scr, int item, int lane, const float* g1, const float* b1, float* part_cs, float* part_bw) {
    const int kb = item >> 6, nb = item & 63, k0 = 64 * kb, n0 = 32 * nb;
    float v[32];
#pragma unroll
    for (int i = 0; i < 32; ++i) { const int kk = 2 * i + (lane >> 5); v[i] = __builtin_nontemporal_load(W + (size_t)(k0 + kk) * 2048 + n0 + (lane & 31)); }
    float cs = 0.f, bw = 0.f;
#pragma unroll
    for (int i = 0; i < 32; ++i) { const int kk = 2 * i + (lane >> 5); const float sv = v[i] * g1[k0 + kk]; scr[kk * 33 + (lane & 31)] = sv; cs += bflo(f2bf(sv)); bw += v[i] * b1[k0 + kk]; }
    cs += __shfl_xor(cs, 32); bw += __shfl_xor(bw, 32);
    if (lane < 32) { part_cs[(size_t)kb * 2048 + n0 + lane] = cs; part_bw[(size_t)kb * 2048 + n0 + lane] = bw; }
    asm volatile("s_waitcnt lgkmcnt(0)" ::: "memory");
    const int c = lane & 7;
#pragma unroll
    for (int j = 0; j < 4; ++j) { const int n = (lane >> 3) + 8 * j; const LAS float* s = scr + (8 * c) * 33 + n;
        u32x4 o; o.x = pk2(s[0 * 33], s[1 * 33]); o.y = pk2(s[2 * 33], s[3 * 33]); o.z = pk2(s[4 * 33], s[5 * 33]); o.w = pk2(s[6 * 33], s[7 * 33]);
        *(u32x4*)(WT + (size_t)(n0 + n) * 2048 + k0 + 8 * c) = o; }
    asm volatile("s_waitcnt lgkmcnt(0)" ::: "memory");
}

__device__ __forceinline__ void phase0(const Args& a, LAS unsigned char* lds) {
    const int tid = threadIdx.x, lane = tid & 63, wave = tid >> 6;
    const int gw = blockIdx.x * NWAVE + wave, NGW = gridDim.x * NWAVE;
    unsigned char* ws = a.ws;
    LAS float* scr = (LAS float*)(lds + wave * 16384);
    if (blockIdx.x == 0) {
        unsigned* lp = (unsigned*)(ws + WS_LNP);
        for (int j = tid; j < 1024; j += NWAVE * 64) { lp[j] = pk2(a.in[12][2 * j], a.in[12][2 * j + 1]); lp[1024 + j] = pk2(a.in[13][2 * j], a.in[13][2 * j + 1]);
            lp[2048 + j] = pk2(a.in[19][2 * j], a.in[19][2 * j + 1]); lp[3072 + j] = pk2(a.in[20][2 * j], a.in[20][2 * j + 1]); }
    }
    for (int t = gw; t < 2048 && (gw & 1) == 0; t += NGW) {
        const int cin0 = (t >> 3) * 4, gI = cin0 >> 8, d0 = (t & 7) * 256 + lane; const float* pw = a.in[5] + (size_t)cin0 * 256; const float* psc = a.in[6] + gI * 256; const float* pp = a.in[7] + (size_t)(gI * 256) * 2048 + d0;
        float acc[4][4];
#pragma unroll
        for (int i = 0; i < 4; ++i)
#pragma unroll
            for (int j = 0; j < 4; ++j) acc[i][j] = 0.f;
        for (int c0 = 0; c0 < 256; c0 += 8) {
            float p[8][4];
#pragma unroll
            for (int cc = 0; cc < 8; ++cc)
#pragma unroll
                for (int j = 0; j < 4; ++j) p[cc][j] = pp[(size_t)(c0 + cc) * 2048 + 64 * j];
#pragma unroll
            for (int cc = 0; cc < 8; ++cc) {
                const int c = c0 + cc; const float sc = psc[c]; const float w0 = pw[c] * sc, w1 = pw[256 + c] * sc, w2 = pw[512 + c] * sc, w3 = pw[768 + c] * sc;
#pragma unroll
                for (int j = 0; j < 4; ++j) { acc[0][j] += w0 * p[cc][j]; acc[1][j] += w1 * p[cc][j]; acc[2][j] += w2 * p[cc][j]; acc[3][j] += w3 * p[cc][j]; }
            }
        }
        bf16_t* W2 = (bf16_t*)(ws + WS_W2_T);
#pragma unroll
        for (int j = 0; j < 4; ++j) { u32x2 o; o.x = pk2(acc[0][j], acc[1][j]); o.y = pk2(acc[2][j], acc[3][j]); *(u32x2*)(W2 + (size_t)(d0 + 64 * j) * 2048 + cin0) = o; }
    }
    for (int r = gw; r < 2 * 16384; r += 2 * NGW) {
        const int rb_ = (r + NGW < 2 * 16384) ? r + NGW : r;
        const int tba = r >> 14, ea = r & 16383, tbb = rb_ >> 14, eb = rb_ & 16383;
        const f32x4* pa = (const f32x4*)(a.in[17 + tba] + (size_t)ea * D) + lane; const f32x4* pb = (const f32x4*)(a.in[17 + tbb] + (size_t)eb * D) + lane;
        f32x4 va[8], vb[8];
#pragma unroll
        for (int m = 0; m < 8; ++m) va[m] = __builtin_nontemporal_load(pa + 64 * m);
#pragma unroll
        for (int m = 0; m < 8; ++m) vb[m] = __builtin_nontemporal_load(pb + 64 * m);
        const int su = (lane & 3) * 16 + (lane >> 2);
        fp4_pack_row(va, (unsigned*)(ws + (tba ? WS_EV : WS_EU) + (size_t)ea * 1024), ws + (tba ? WS_EV : WS_EU) + EXP_SC_OFF + (size_t)ea * 64, tba ? lane : su, lane);
        fp4_pack_row(vb, (unsigned*)(ws + (tbb ? WS_EV : WS_EU) + (size_t)eb * 1024), ws + (tbb ? WS_EV : WS_EU) + EXP_SC_OFF + (size_t)eb * 64, tbb ? lane : su, lane);
    }
    for (int m = gw; m < M + NMETA; m += 2 * NGW) {
        const int mb = (m + NGW < M + NMETA) ? m + NGW : m;
        const float* xa = m < M ? a.in[0] + (size_t)m * D : a.in[1] + (size_t)(m - M) * D; bf16_t* oa = m < M ? (bf16_t*)(ws + WS_H0) + (size_t)m * D : (bf16_t*)(ws + WS_HM) + (size_t)(m - M) * D;
        const float* xb = mb < M ? a.in[0] + (size_t)mb * D : a.in[1] + (size_t)(mb - M) * D; bf16_t* ob = mb < M ? (bf16_t*)(ws + WS_H0) + (size_t)mb * D : (bf16_t*)(ws + WS_HM) + (size_t)(mb - M) * D;
        float* SA = (float*)(ws + WS_SA);
        ln_2rows(xa, oa, m < M ? (unsigned*)(ws + WS_H0_8 + (size_t)m * 2048) : nullptr, SA + (m < M ? m : 0), xb, ob, mb < M ? (unsigned*)(ws + WS_H0_8 + (size_t)mb * 2048) : nullptr, SA + (mb < M ? mb : 0), a.in[2], a.in[3], lane);
    }
    constexpr int I_WIN = (2048 / 64) * (8192 / 32), I_PP = (1024 / 64) * (2048 / 32), I_WO = (2048 / 64) * (2048 / 32);
    constexpr int NITEMS = I_WIN + I_PP + 2 * I_WO;
    for (int it = gw; it < NITEMS; it += NGW) {
        int r = it;
        if (r < I_WIN) { transpose_item(a.in[4], 8192, (bf16_t*)(ws + WS_WIN_T), 2048, 0, scr, r, lane, nullptr, (unsigned*)(ws + WS_CAMAX)); continue; } r -= I_WIN;
        if (r < I_PP) { transpose_item(a.in[10], 2048, (bf16_t*)(ws + WS_W2_T), 2048, 1024, scr, r, lane); continue; } r -= I_PP;
        if (r < I_WO) { transpose_item(a.in[11], 2048, (bf16_t*)(ws + WS_WO_T), 2048, 0, scr, r, lane); continue; } r -= I_WO;
        transpose_item_wq(a.in[14], (bf16_t*)(ws + WS_WQ_T), scr, r, lane, a.in[12], a.in[13], (float*)(ws + WS_POOLED), (float*)(ws + WS_POOLED + 256 * 1024));
    }
    for (int t = gw; t < 2048 && (gw & 1) == 1; t += NGW) {
        const int cin0 = (t >> 3) * 4, gI = cin0 >> 8, d0 = (t & 7) * 256 + lane; const float* pw = a.in[5] + (size_t)cin0 * 256; const float* psc = a.in[6] + gI * 256; const float* pp = a.in[7] + (size_t)(gI * 256) * 2048 + d0;
        float acc[4][4];
#pragma unroll
        for (int i = 0; i < 4; ++i)
#pragma unroll
            for (int j = 0; j < 4; ++j) acc[i][j] = 0.f;
        for (int c0 = 0; c0 < 256; c0 += 8) {
            float p[8][4];
#pragma unroll
            for (int cc = 0; cc < 8; ++cc)
#pragma unroll
                for (int j = 0; j < 4; ++j) p[cc][j] = pp[(size_t)(c0 + cc) * 2048 + 64 * j];
#pragma unroll
            for (int cc = 0; cc < 8; ++cc) {
                const int c = c0 + cc; const float sc = psc[c]; const float w0 = pw[c] * sc, w1 = pw[256 + c] * sc, w2 = pw[512 + c] * sc, w3 = pw[768 + c] * sc;
#pragma unroll
                for (int j = 0; j < 4; ++j) { acc[0][j] += w0 * p[cc][j]; acc[1][j] += w1 * p[cc][j]; acc[2][j] += w2 * p[cc][j]; acc[3][j] += w3 * p[cc][j]; }
            }
        }
        bf16_t* W2 = (bf16_t*)(ws + WS_W2_T);
#pragma unroll
        for (int j = 0; j < 4; ++j) { u32x2 o; o.x = pk2(acc[0][j], acc[1][j]); o.y = pk2(acc[2][j], acc[3][j]); *(u32x2*)(W2 + (size_t)(d0 + 64 * j) * 2048 + cin0) = o; }
    }
    const size_t gt = (size_t)blockIdx.x * NTH + tid, ngt = (size_t)gridDim.x * NTH;
    { unsigned long long* st = (unsigned long long*)(ws + WS_STATS); for (size_t i = gt; i < (size_t)2 * M; i += ngt) st[i] = 0ull; }
    cvt_flat(a.in[15], (bf16_t*)(ws + WS_KEYS), (size_t)8 * 128 * 128 / 8, gt, ngt);
    cvt_flat(a.in[16], (bf16_t*)(ws + WS_KEYS) + 8 * 128 * 128, (size_t)8 * 128 * 128 / 8, gt, ngt);
}
__device__ __forceinline__ void phase0b(const Args& a) {
    const int lane = threadIdx.x & 63, gw = blockIdx.x * NWAVE + (threadIdx.x >> 6), NGW = gridDim.x * NWAVE;
    const bf16_t* WT = (const bf16_t*)(a.ws + WS_WIN_T); unsigned char* W8 = a.ws + WS_WIN8; const float* cmx = (const float*)(a.ws + WS_CAMAX);
    for (int n = gw; n < 8192; n += 2 * NGW) {
        const int nb = (n + NGW < 8192) ? n + NGW : n;
        const u32x4* pa = (const u32x4*)(WT + (size_t)n * 2048) + lane; const u32x4* pb = (const u32x4*)(WT + (size_t)nb * 2048) + lane;
        u32x4 wa[4], wb[4];
#pragma unroll
        for (int q = 0; q < 4; ++q) { wa[q] = pa[64 * q]; wb[q] = pb[64 * q]; }
        const float ca = cmx[n], cb = cmx[nb], ia = ca > 0.f ? 127.0f / ca : 0.f, ib = cb > 0.f ? 127.0f / cb : 0.f;
#pragma unroll
        for (int q = 0; q < 4; ++q) {
            u32x2 o; o.x = pack_i8x4(bflo(wa[q].x) * ia, bfhi(wa[q].x) * ia, bflo(wa[q].y) * ia, bfhi(wa[q].y) * ia); o.y = pack_i8x4(bflo(wa[q].z) * ia, bfhi(wa[q].z) * ia, bflo(wa[q].w) * ia, bfhi(wa[q].w) * ia);
            *((u32x2*)(W8 + (size_t)n * 2048) + lane + 64 * q) = o;
            o.x = pack_i8x4(bflo(wb[q].x) * ib, bfhi(wb[q].x) * ib, bflo(wb[q].y) * ib, bfhi(wb[q].y) * ib); o.y = pack_i8x4(bflo(wb[q].z) * ib, bfhi(wb[q].z) * ib, bflo(wb[q].w) * ib, bfhi(wb[q].w) * ib);
            *((u32x2*)(W8 + (size_t)nb * 2048) + lane + 64 * q) = o; }
    }
}
__device__ __forceinline__ void ln1_fold_vectors(const Args& a) {
    const int gid = blockIdx.x * NTH + threadIdx.x;
    if (gid >= 4096) return;
    const int which = gid >> 11, n = gid & 2047; const float* part = (const float*)(a.ws + WS_POOLED + (which ? 256 * 1024 : 0));
    float s = 0.f;
#pragma unroll
    for (int kb = 0; kb < 32; ++kb) s += part[(size_t)kb * 2048 + n];
    ((float*)(a.ws + (which ? WS_BW : WS_CS)))[n] = s;
}

__device__ __forceinline__ void meta_proj(const Args& a) {
    const int lane = threadIdx.x & 63, gw = blockIdx.x * NWAVE + (threadIdx.x >> 6), NGW = gridDim.x * NWAVE;
    for (int ci = gw; ci < 3072; ci += NGW) {
        const int seg = ci >> 10, c = ci & 1023, col = (seg == 0 ? 0 : (seg == 1 ? 1024 : 3072)) + c;
        const u32x4* wp = (const u32x4*)((const bf16_t*)(a.ws + WS_WIN_T) + (size_t)col * D + lane * 32);
        float wv[32];
#pragma unroll
        for (int q = 0; q < 4; ++q) { const u32x4 w = wp[q]; wv[8 * q + 0] = bflo(w.x); wv[8 * q + 1] = bfhi(w.x); wv[8 * q + 2] = bflo(w.y); wv[8 * q + 3] = bfhi(w.y); wv[8 * q + 4] = bflo(w.z); wv[8 * q + 5] = bfhi(w.z); wv[8 * q + 6] = bflo(w.w); wv[8 * q + 7] = bfhi(w.w); }
        float mine = 0.f;
#pragma unroll
        for (int r = 0; r < 16; ++r) {
            const u32x4* hp = (const u32x4*)((const bf16_t*)(a.ws + WS_HM) + (size_t)r * D + lane * 32);
            float s = 0.f;
#pragma unroll
            for (int q = 0; q < 4; ++q) { const u32x4 h = hp[q];
                s += bflo(h.x) * wv[8 * q + 0] + bfhi(h.x) * wv[8 * q + 1] + bflo(h.y) * wv[8 * q + 2] + bfhi(h.y) * wv[8 * q + 3] + bflo(h.z) * wv[8 * q + 4] + bfhi(h.z) * wv[8 * q + 5] + bflo(h.w) * wv[8 * q + 6] + bfhi(h.w) * wv[8 * q + 7]; }
            s = wave_sum(s);
            mine = (lane == r) ? s : mine;
        }
        if (lane < 16) ((float*)(a.ws + WS_PMETA))[(size_t)lane * 3072 + seg * 1024 + c] = mine;
    }
}

__device__ __forceinline__ void unpack8(const u32x4 v, float (&f)[8]) { f[0] = bflo(v.x); f[1] = bfhi(v.x); f[2] = bflo(v.y); f[3] = bfhi(v.y); f[4] = bflo(v.z); f[5] = bfhi(v.z); f[6] = bflo(v.w); f[7] = bfhi(v.w); }
__device__ __forceinline__ void load8_f32(const float* p, float (&f)[8]) { const f32x4 a = *(const f32x4*)p, b = *(const f32x4*)(p + 4); f[0] = a[0]; f[1] = a[1]; f[2] = a[2]; f[3] = a[3]; f[4] = b[0]; f[5] = b[1]; f[6] = b[2]; f[7] = b[3]; }
__device__ __forceinline__ void p2_get(const bf16_t* PAZ, const float* PMETA, int r, int s, int delta, int paz_col, int meta_col, float (&f)[8]) {
    if (s + delta >= 0) unpack8(*(const u32x4*)(PAZ + (size_t)(r + delta) * 4096 + paz_col), f);
    else load8_f32(PMETA + (size_t)(NMETA + s + delta) * 3072 + meta_col, f);
}
__device__ __forceinline__ void phase2(const Args& a) {
    const bf16_t* PAZ = (const bf16_t*)(a.ws + WS_PAZ); const float* PMETA = (const float*)(a.ws + WS_PMETA);
    bf16_t* A2 = (bf16_t*)(a.ws + WS_A2);
    const float* conv_w = a.in[8]; const float* conv_b = a.in[9];
    const int total = (M / 16) * 128;
    for (int idx = blockIdx.x * NTH + threadIdx.x; idx < total; idx += gridDim.x * NTH) {
        const int c8 = idx & 127, c = c8 * 8, r0 = (idx >> 7) * 16, s0 = r0 & (SEQ - 1);
        const int g = c8 >> 5, w = 2 << g; const float inv = 1.0f / (float)w;
        float S[8], u1[8], u2[8], w0[8], w1[8], w2[8], cb[8];
        load8_f32(conv_w + c, w0); load8_f32(conv_w + 1024 + c, w1); load8_f32(conv_w + 2048 + c, w2); load8_f32(conv_b + c, cb);
#pragma unroll
        for (int i = 0; i < 8; ++i) S[i] = 0.f;
        for (int j = 1; j <= w; ++j) { float f[8]; p2_get(PAZ, PMETA, r0, s0, -j, c, c, f);
#pragma unroll
            for (int i = 0; i < 8; ++i) S[i] += f[i]; }
        { float zh[8], zc[8]; p2_get(PAZ, PMETA, r0, s0, -1, 1024 + c, 1024 + c, zh); p2_get(PAZ, PMETA, r0, s0, -1, 3072 + c, 2048 + c, zc);
#pragma unroll
          for (int i = 0; i < 8; ++i) u1[i] = zh[i] * zc[i];
          p2_get(PAZ, PMETA, r0, s0, -2, 1024 + c, 1024 + c, zh); p2_get(PAZ, PMETA, r0, s0, -2, 3072 + c, 2048 + c, zc);
#pragma unroll
          for (int i = 0; i < 8; ++i) u2[i] = zh[i] * zc[i]; }
#pragma unroll 4
        for (int t = 0; t < 16; ++t) {
            const int r = r0 + t, s = s0 + t;
            float an[8], ao[8], zh[8], zc[8], zb[8];
            unpack8(*(const u32x4*)(PAZ + (size_t)r * 4096 + c), an);
            p2_get(PAZ, PMETA, r, s, -w, c, c, ao);
            unpack8(__builtin_nontemporal_load((const u32x4*)(PAZ + (size_t)r * 4096 + 1024 + c)), zh); unpack8(__builtin_nontemporal_load((const u32x4*)(PAZ + (size_t)r * 4096 + 2048 + c)), zb); unpack8(__builtin_nontemporal_load((const u32x4*)(PAZ + (size_t)r * 4096 + 3072 + c)), zc);
            float po[8], yo[8];
#pragma unroll
            for (int i = 0; i < 8; ++i) { S[i] += an[i] - ao[i]; po[i] = S[i] * inv - an[i];
                const float u0 = zh[i] * zc[i]; yo[i] = zb[i] * (cb[i] + w2[i] * u0 + w1[i] * u1[i] + w0[i] * u2[i]); u2[i] = u1[i]; u1[i] = u0; }
            u32x4 o; o.x = pk2(po[0], po[1]); o.y = pk2(po[2], po[3]); o.z = pk2(po[4], po[5]); o.w = pk2(po[6], po[7]);
            *(u32x4*)(A2 + (size_t)r * 2048 + c) = o;
            o.x = pk2(yo[0], yo[1]); o.y = pk2(yo[2], yo[3]); o.z = pk2(yo[4], yo[5]); o.w = pk2(yo[6], yo[7]);
            *(u32x4*)(A2 + (size_t)r * 2048 + 1024 + c) = o;
        }
    }
}

__device__ __forceinline__ void phase_ln1(const Args& a) {
    const int lane = threadIdx.x & 63, gw = blockIdx.x * NWAVE + (threadIdx.x >> 6), NGW = gridDim.x * NWAVE;
    bf16_t* R1 = (bf16_t*)(a.ws + WS_A2); const float* g = a.in[12]; const float* b = a.in[13];
    for (int m = gw; m < M; m += NGW) {
        u32x4* rp = (u32x4*)(R1 + (size_t)m * D) + lane;
        float v[4][8]; float s = 0.f;
#pragma unroll
        for (int j = 0; j < 4; ++j) { unpack8(rp[64 * j], v[j]);
#pragma unroll
            for (int i = 0; i < 8; ++i) s += v[j][i]; }
        const float mean = wave_sum(s) * (1.f / D); float s2 = 0.f;
#pragma unroll
        for (int j = 0; j < 4; ++j)
#pragma unroll
            for (int i = 0; i < 8; ++i) { v[j][i] -= mean; s2 += v[j][i] * v[j][i]; }
        const float rstd = rsqrtf(wave_sum(s2) * (1.f / D) + LN_EPS);
#pragma unroll
        for (int j = 0; j < 4; ++j) { float gg[8], bb[8]; load8_f32(g + j * 512 + lane * 8, gg); load8_f32(b + j * 512 + lane * 8, bb);
            float y[8];
#pragma unroll
            for (int i = 0; i < 8; ++i) y[i] = v[j][i] * rstd * gg[i] + bb[i];
            u32x4 o; o.x = pk2(y[0], y[1]); o.y = pk2(y[2], y[3]); o.z = pk2(y[4], y[5]); o.w = pk2(y[6], y[7]); rp[64 * j] = o; }
    }
}

__host__ __device__ constexpr int stair_code(int idx) {
    int cnt = 0;
    for (int aa = 0; aa < 16; ++aa) for (int bb = 0; bb < 16; ++bb) if ((aa + 1) * (bb + 1) <= 16) { if (cnt == idx) return aa * 16 + bb; ++cnt; }
    return 0;
}
__device__ __forceinline__ unsigned umax_(unsigned a, unsigned b) { return a > b ? a : b; }
__device__ __forceinline__ unsigned umin_(unsigned a, unsigned b) { return a < b ? a : b; }
__device__ __forceinline__ void bitonic_sort16_desc(unsigned (&v)[16]) {
#pragma unroll
    for (int k = 2; k <= 16; k <<= 1)
#pragma unroll
        for (int j = k >> 1; j > 0; j >>= 1)
#pragma unroll
            for (int i = 0; i < 16; ++i) { const int l = i ^ j;
                if (l > i) { const unsigned a = v[i], b = v[l], mx = umax_(a, b), mn = umin_(a, b); const bool desc = ((i & k) == 0); v[i] = desc ? mx : mn; v[l] = desc ? mn : mx; } }
}
__device__ __forceinline__ void merge_top16(unsigned (&a)[16], const unsigned (&b)[16]) {
#pragma unroll
    for (int i = 0; i < 16; ++i) a[i] = umax_(a[i], b[15 - i]);
#pragma unroll
    for (int j = 8; j > 0; j >>= 1)
#pragma unroll
        for (int i = 0; i < 16; ++i) { const int l = i ^ j; if (l > i) { const unsigned x = a[i], y = a[l]; a[i] = umax_(x, y); a[l] = umin_(x, y); } }
}

__device__ __forceinline__ void p7_task(const bf16_t* Q, const LAS unsigned char* kl  , int* IDX, float* GATE, LAS unsigned* wl, int grp, int h, int lane) {
    const int tk = lane & 31, hh = lane >> 5, token = grp * 32 + tk;
#pragma unroll 1
    for (int side = 0; side < 2; ++side) {
        f32x16 acc[4];
#pragma unroll
        for (int nb = 0; nb < 4; ++nb)
#pragma unroll
            for (int r = 0; r < 16; ++r) acc[nb][r] = 0.f;
        const bf16_t* qp = Q + (size_t)token * D + h * 256 + side * 128 + 8 * hh;
        const LAS unsigned char* kp = kl + side * 32768 + tk * 256;
#pragma unroll
        for (int ks = 0; ks < 8; ++ks) {
            const bf16x8 bq = *(const bf16x8*)(qp + ks * 16);
#pragma unroll
            for (int nb = 0; nb < 4; ++nb) {
                const bf16x8 ak = *(const LAS bf16x8*)(kp + nb * 8192 + (((2 * ks + hh) ^ (tk & 15)) << 4));
                acc[nb] = __builtin_amdgcn_mfma_f32_32x32x16_bf16(ak, bq, acc[nb], 0, 0, 0);
            }
        }
        unsigned pk[4][16];
#pragma unroll
        for (int nb = 0; nb < 4; ++nb)
#pragma unroll
            for (int r = 0; r < 16; ++r) { const unsigned n = (unsigned)(nb * 32 + (r & 3) + 8 * (r >> 2)) + 4u * (unsigned)hh; pk[nb][r] = (ord_f32(acc[nb][r]) & ~127u) | (127u - n); }
        bitonic_sort16_desc(pk[0]); bitonic_sort16_desc(pk[1]); bitonic_sort16_desc(pk[2]); bitonic_sort16_desc(pk[3]);
        merge_top16(pk[0], pk[1]); merge_top16(pk[2], pk[3]); merge_top16(pk[0], pk[2]);
        unsigned pb[16];
#pragma unroll
        for (int i = 0; i < 16; ++i) { const auto sw = __builtin_amdgcn_permlane32_swap(pk[0][i], pk[0][i], false, false); pb[i] = hh ? sw[0] : sw[1]; }
        merge_top16(pk[0], pb);
        if (hh == 0) {
#pragma unroll
            for (int i = 0; i < 16; ++i) wl[(side * 32 + tk) * 16 + i] = pk[0][i];
        }
    }
    unsigned ck[25];
#define P7_CK(i) { constexpr int c0 = stair_code(2 * (i)), c1 = stair_code(2 * (i) + 1); const int cc = hh ? c1 : c0; const int ca = cc >> 4, cb = cc & 15; \
        const unsigned v1 = wl[(0 * 32 + tk) * 16 + ca], v2 = wl[(1 * 32 + tk) * 16 + cb]; const float sm = unord_f32(v1 & ~127u) + unord_f32(v2 & ~127u); \
        ck[i] = (ord_f32(sm) & ~255u) | (255u - (unsigned)cc); }
    P7_CK(0) P7_CK(1) P7_CK(2) P7_CK(3) P7_CK(4) P7_CK(5) P7_CK(6) P7_CK(7) P7_CK(8) P7_CK(9) P7_CK(10) P7_CK(11) P7_CK(12)
    P7_CK(13) P7_CK(14) P7_CK(15) P7_CK(16) P7_CK(17) P7_CK(18) P7_CK(19) P7_CK(20) P7_CK(21) P7_CK(22) P7_CK(23) P7_CK(24)
#undef P7_CK
#pragma unroll 1
    for (int rd = 0; rd < 16; ++rd) {
        unsigned m = ck[0];
#pragma unroll
        for (int i = 1; i < 25; ++i) m = umax_(m, ck[i]);
        m = umax_(m, (unsigned)__shfl_xor((int)m, 32));
#pragma unroll
        for (int i = 0; i < 25; ++i) ck[i] = (ck[i] == m) ? 0u : ck[i];
        if (hh == 0) wl[1024 + tk * 16 + rd] = m;
    }
    const float s0 = unord_f32(wl[1024 + tk * 16] & ~255u);
    float p0, p1, p2, p3, p4, p5, p6, p7; int e0, e1, e2, e3, e4, e5, e6, e7;
#define P7_FIN(r, pv, evv) { const unsigned m = wl[1024 + tk * 16 + 8 * hh + (r)]; const unsigned code = 255u - (m & 255u); const int ca = (int)(code >> 4), cb = (int)(code & 15u); \
        const unsigned v1 = wl[(0 * 32 + tk) * 16 + ca], v2 = wl[(1 * 32 + tk) * 16 + cb]; \
        pv = __expf(unord_f32(m & ~255u) - s0); evv = (int)(127u - (v1 & 127u)) * 128 + (int)(127u - (v2 & 127u)); }
    P7_FIN(0, p0, e0) P7_FIN(1, p1, e1) P7_FIN(2, p2, e2) P7_FIN(3, p3, e3) P7_FIN(4, p4, e4) P7_FIN(5, p5, e5) P7_FIN(6, p6, e6) P7_FIN(7, p7, e7)
#undef P7_FIN
    float Z = ((p0 + p1) + (p2 + p3)) + ((p4 + p5) + (p6 + p7));
    Z += __shfl_xor(Z, 32);
    const float iz = 1.0f / Z;
    int* ip = IDX + (size_t)token * 128 + h * 16 + hh * 8; float* gp = GATE + (size_t)token * 128 + h * 16 + hh * 8;
    ip[0] = e0; ip[1] = e1; ip[2] = e2; ip[3] = e3; ip[4] = e4; ip[5] = e5; ip[6] = e6; ip[7] = e7;
    gp[0] = p0 * iz; gp[1] = p1 * iz; gp[2] = p2 * iz; gp[3] = p3 * iz; gp[4] = p4 * iz; gp[5] = p5 * iz; gp[6] = p6 * iz; gp[7] = p7 * iz;
}
__device__ __forceinline__ void phase7(const Args& a, LAS unsigned char* lds) {
    const int tid = threadIdx.x, lane = tid & 63, wave = tid >> 6;
    const int h = blockIdx.x & 7, bq = blockIdx.x >> 3, nbh = ((int)gridDim.x - h + 7) >> 3;
    const bf16_t* KEYS = (const bf16_t*)(a.ws + WS_KEYS);
    for (int i = tid; i < 4096; i += NTH) { const int s = i >> 11, n = (i >> 4) & 127, c8 = i & 15;
        const u32x4 v = *(const u32x4*)(KEYS + ((size_t)(s * 8 + h) * 128 + n) * 128 + c8 * 8);
        *(LAS u32x4*)(lds + s * 32768 + n * 256 + ((c8 ^ (n & 15)) << 4)) = v; }
    __syncthreads();
    LAS unsigned* wl = (LAS unsigned*)(lds + 65536 + wave * 8192);
    const bf16_t* Q = (const bf16_t*)(a.ws + WS_PAZ + 64 * MiB);
    int* IDX = (int*)(a.ws + WS_POOLED); float* GATE = (float*)(a.ws + WS_POOLED + 8 * MiB);
    for (int g = bq * NWAVE + wave; g < M / 32; g += nbh * NWAVE) p7_task(Q, lds, IDX, GATE, wl, g, h, lane);
    __syncthreads();
}

typedef float f32x2 __attribute__((ext_vector_type(2)));
#ifndef P8_AUX
#define P8_AUX 0
#endif
template <int CTRL> __device__ __forceinline__ float dpp_f(float v) { return __int_as_float(__builtin_amdgcn_update_dpp(0, __float_as_int(v), CTRL, 0xf, 0xf, false)); }
struct UGrp { int t0, t1, t2, t3, pkr; };
constexpr int U_WAVE_LDS = 20304;
__device__ __forceinline__ void phase_u(const Args& a, LAS unsigned char* lds) {
    typedef int v8i_ __attribute__((ext_vector_type(8)));
    int lane = threadIdx.x & 63; const int wave = __builtin_amdgcn_readfirstlane((int)(threadIdx.x >> 6)), gw = blockIdx.x * NWAVE + wave, NGW = gridDim.x * NWAVE;
    LAS unsigned char* wl = lds + wave * U_WAVE_LDS;
    LAS unsigned short* elist = (LAS unsigned short*)(wl + 17408);
    LAS int* offT = (LAS int*)(wl + 19456);
    LAS unsigned short* cst = (LAS unsigned short*)(wl + 20032);
    const bf16_t* R1 = (const bf16_t*)(a.ws + WS_A2);
    int* IDX = (int*)(a.ws + WS_POOLED); float* GATE = (float*)(a.ws + WS_POOLED + 8 * MiB); float* ACT = (float*)(a.ws + WS_POOLED + 16 * MiB);
    float* dump = (float*)(a.ws + WS_POOLED + 24 * MiB) + (size_t)gw * 64;
    const __amdgpu_buffer_rsrc_t ru = __builtin_amdgcn_make_buffer_rsrc((void*)(a.ws + WS_EU), 0, 16 * 1024 * 1024, 0x00020000);
    const __amdgpu_buffer_rsrc_t rsc = __builtin_amdgcn_make_buffer_rsrc((void*)(a.ws + WS_EU + EXP_SC_OFF), 0, 1024 * 1024, 0x00020000);
#pragma unroll 1
    for (int tb = gw; tb < M / 8; tb += NGW) {
        const int tok0 = __builtin_amdgcn_readfirstlane(tb * 8);
        int el[8], eh[8]; float gl[8], gh[8];
#pragma unroll
        for (int t = 0; t < 8; ++t) { const size_t o = (size_t)(tok0 + t) * 128; el[t] = IDX[o + lane]; eh[t] = IDX[o + 64 + lane]; gl[t] = GATE[o + lane]; gh[t] = GATE[o + 64 + lane]; }
#pragma unroll
        for (int t = 0; t < 8; ++t) {
            const size_t o = (size_t)(tok0 + t) * 128;
            const int e_lo = el[t], e_hi = eh[t]; const float g_lo = gl[t], g_hi = gh[t];
            const int b_lo = e_lo >> 10, b_hi = e_hi >> 10; int base = 0, pos_lo = 0, pos_hi = 0;
#pragma unroll 1
            for (int b = 0; b < 16; ++b) {
                const unsigned long long m0 = __ballot(b_lo == b), m1 = __ballot(b_hi == b);
                const int c0 = __popcll(m0), c1 = __popcll(m1);
                const int r0 = __builtin_amdgcn_mbcnt_hi((unsigned)(m0 >> 32), __builtin_amdgcn_mbcnt_lo((unsigned)m0, 0u));
                const int r1 = __builtin_amdgcn_mbcnt_hi((unsigned)(m1 >> 32), __builtin_amdgcn_mbcnt_lo((unsigned)m1, 0u));
                if (lane == 0) offT[t * 18 + b] = base;
                pos_lo = (b_lo == b) ? base + r0 : pos_lo; pos_hi = (b_hi == b) ? base + c0 + r1 : pos_hi;
                base += c0 + c1;
            }
            if (lane == 0) offT[t * 18 + 16] = 128;
            IDX[o + pos_lo] = e_lo; IDX[o + pos_hi] = e_hi; GATE[o + pos_lo] = g_lo; GATE[o + pos_hi] = g_hi;
            elist[t * 128 + pos_lo] = (unsigned short)e_lo; elist[t * 128 + pos_hi] = (unsigned short)e_hi;
        }
        asm volatile("s_waitcnt lgkmcnt(0)" ::: "memory");
        { const int c0i = 2 * lane, bb = c0i >> 3, t0 = c0i & 7;
          const int n0 = offT[t0 * 18 + bb + 1] - offT[t0 * 18 + bb], n1 = offT[(t0 + 1) * 18 + bb + 1] - offT[(t0 + 1) * 18 + bb];
          int inc = n0 + n1;
#pragma unroll
          for (int o = 1; o < 64; o <<= 1) { const int up = __shfl_up(inc, o); inc += (lane >= o) ? up : 0; }
          const int pre = inc - (n0 + n1);
          cst[c0i] = (unsigned short)pre; cst[c0i + 1] = (unsigned short)(pre + n0);
          if (lane == 63) cst[128] = (unsigned short)1024; }
        asm volatile("s_waitcnt lgkmcnt(0)" ::: "memory");
        v8i_ XF[16];
#pragma unroll
        for (int j = 0; j < 16; ++j) XF[j] = (v8i_){0, 0, 0, 0, 0, 0, 0, 0};
        {
            asm volatile("" : "+v"(lane));
            const int n16 = lane & 15, kq = lane >> 4;
            const int wbase = (lane >> 2) * 128 + (lane & 1) * 64 + ((lane >> 1) & 1) * 16;
            const int rbase = ((n16 >> 1) & 3) * 4096 + (n16 & 1) * 2048 + kq * 32;
            const f32x4* g14 = (const f32x4*)a.in[12] + lane; const f32x4* b14 = (const f32x4*)a.in[13] + lane;
            u32x2 rw[8]; long long st_s, st_q;
            { const long long* st1 = (const long long*)(a.ws + WS_STATS) + 2 * (size_t)tok0; st_s = st1[0]; st_q = st1[1];
              const u32x2* hp = (const u32x2*)(R1 + (size_t)tok0 * D) + lane;
#pragma unroll
              for (int m = 0; m < 8; ++m) rw[m] = hp[64 * m]; }
#pragma unroll 1
            for (int k = 0; k < 8; ++k) {
                const int tt = k & 3, hh = k >> 2, tokn = tok0 + (k < 7 ? k + 1 : k);
                u32x2 rn[8]; long long sn_s, sn_q;
                { const long long* st1 = (const long long*)(a.ws + WS_STATS) + 2 * (size_t)tokn; sn_s = st1[0]; sn_q = st1[1];
                  const u32x2* hp = (const u32x2*)(R1 + (size_t)tokn * D) + lane;
#pragma unroll
                  for (int m = 0; m < 8; ++m) rn[m] = hp[64 * m]; }
                const float sm1 = (float)st_s * (1.0f / STAT_FX), sq1 = (float)st_q * (1.0f / STAT_FX);
                const float mean1 = sm1 * (1.0f / D), rstd1 = rsqrtf(fmaxf(sq1 * (1.0f / D) - mean1 * mean1, 0.f) + LN_EPS);
#pragma unroll
                for (int m = 0; m < 8; ++m) { const u32x2 w = rw[m]; const f32x4 gg = g14[64 * m], bb = b14[64 * m];
                    const float x0 = (bflo(w.x) - mean1) * rstd1 * gg[0] + bb[0], x1 = (bfhi(w.x) - mean1) * rstd1 * gg[1] + bb[1], x2 = (bflo(w.y) - mean1) * rstd1 * gg[2] + bb[2], x3 = (bfhi(w.y) - mean1) * rstd1 * gg[3] + bb[3];
                    int hi = 0; hi = __builtin_amdgcn_cvt_pk_fp8_f32(x0, x1, hi, false); hi = __builtin_amdgcn_cvt_pk_fp8_f32(x2, x3, hi, true);
                    const f32x2 h01 = __builtin_amdgcn_cvt_pk_f32_fp8(hi, false), h23 = __builtin_amdgcn_cvt_pk_f32_fp8(hi, true);
                    int lo = 0; lo = __builtin_amdgcn_cvt_pk_fp8_f32((x0 - h01.x) * 32.0f, (x1 - h01.y) * 32.0f, lo, false); lo = __builtin_amdgcn_cvt_pk_fp8_f32((x2 - h23.x) * 32.0f, (x3 - h23.y) * 32.0f, lo, true);
                    LAS int* wp = (LAS int*)(wl + tt * 4096 + wbase + (m >> 2) * 32 + (m & 3) * 4);
                    wp[0] = hi; wp[512] = lo; }
                if (tt == 3) {
                    asm volatile("s_waitcnt lgkmcnt(0)" ::: "memory");
                    if ((n16 >> 3) == hh) {
#pragma unroll
                        for (int j = 0; j < 16; ++j) { const u32x4 q0 = *(const LAS u32x4*)(wl + rbase + j * 128), q1 = *(const LAS u32x4*)(wl + rbase + j * 128 + 16);
                            XF[j] = (v8i_){(int)q0[0], (int)q0[1], (int)q0[2], (int)q0[3], (int)q1[0], (int)q1[1], (int)q1[2], (int)q1[3]}; }
                    }
                    asm volatile("s_waitcnt lgkmcnt(0)" ::: "memory");
                }
#pragma unroll
                for (int m = 0; m < 8; ++m) rw[m] = rn[m];
                st_s = sn_s; st_q = sn_q;
            }
        }
        asm volatile("" : "+v"(lane));
        const int n16 = lane & 15, kq = lane >> 4;
        int rb[4];
#pragma unroll
        for (int jj = 0; jj < 4; ++jj) rb[jj] = n16 * 256 + (4 * (jj ^ (n16 >> 2)) + (kq ^ (n16 & 3))) * 16;
        const int xbase = ((lane & 15) ^ (lane >> 4)) * 16;
        const int scrd = 16384 + n16 * 64 + kq * 16;
        const int bscale = (n16 & 1) ? 0x7A : 0x7F;
        int rnd = -1, g = 3;
        int e_vec = 0, pk_vec = -1;
        auto advance = [&]() __attribute__((always_inline)) -> bool {
            ++g; if (g < 4) return true;
            ++rnd; if (rnd >= 16) return false;
            const int q = 64 * rnd + lane; int c = 0, base = 0;
#pragma unroll
            for (int step = 64; step >= 1; step >>= 1) { const int v = (int)cst[c + step]; const bool ge = v <= q; c = ge ? c + step : c; base = ge ? v : base; }
            const int t = c & 7, pos = offT[t * 18 + (c >> 3)] + (q - base);
            e_vec = (int)elist[t * 128 + pos]; pk_vec = t * 128 + pos;
            g = 0; return true;
        };
        int vo[4], vsc;
        auto prepare = [&](UGrp& G) __attribute__((always_inline)) {
            const int l0 = 16 * g, tb4 = 4 * (l0 + 4 * kq);
            G.t0 = __builtin_amdgcn_ds_bpermute(tb4, pk_vec); G.t1 = __builtin_amdgcn_ds_bpermute(tb4 + 4, pk_vec); G.t2 = __builtin_amdgcn_ds_bpermute(tb4 + 8, pk_vec); G.t3 = __builtin_amdgcn_ds_bpermute(tb4 + 12, pk_vec);
            G.pkr = __builtin_amdgcn_ds_bpermute(tb4 + 4 * (n16 & 3), pk_vec);
#pragma unroll
            for (int i = 0; i < 4; ++i) vo[i] = __builtin_amdgcn_ds_bpermute(4 * (l0 + 4 * i + kq), e_vec) * 1024 + (xbase ^ (64 * i));
            vsc = __builtin_amdgcn_ds_bpermute(4 * (l0 + (lane >> 2)), e_vec) * 64 + (lane & 3) * 16;
        };
#define U_SCDMA() __builtin_amdgcn_raw_ptr_buffer_load_lds(rsc, (LAS unsigned*)(wl + 16384), 16, vsc, 0, 0, 0)
#define U_DMA(q) { _Pragma("unroll") for (int i = 0; i < 4; ++i) __builtin_amdgcn_raw_ptr_buffer_load_lds(ru, (LAS unsigned*)(wl + (q) * 4096 + i * 1024), 16, vo[i], (q) * 256, 0, 0); }
#define U_MMA(j) { const u32x4 qa = *(const LAS u32x4*)(wl + rb[(j) & 3] + ((j) >> 2) * 4096); const v8i_ a8 = (v8i_){(int)qa[0], (int)qa[1], (int)qa[2], (int)qa[3], 0, 0, 0, 0}; \
            acc = __builtin_amdgcn_mfma_scale_f32_16x16x128_f8f6f4(a8, XF[j], acc, 4  , 0  , (j) & 3  , (int)SCr[(j) >> 2], 0, bscale); }
#define U_Q(q) { U_MMA(4 * (q)) U_MMA(4 * (q) + 1) U_MMA(4 * (q) + 2) U_MMA(4 * (q) + 3) asm volatile("s_waitcnt lgkmcnt(0)" : "+v"(acc) :: "memory"); __builtin_amdgcn_sched_barrier(0); }
#define U_WAIT(n) asm volatile("s_waitcnt vmcnt(" #n ")" ::: "memory")
        UGrp Gc, Gn; int it = 0; float sacc = 0.f; int pkacc = -1;
        bool more = advance();
        prepare(Gc);
        U_SCDMA(); U_DMA(0) U_DMA(1) U_DMA(2) U_DMA(3)
#pragma unroll 1
        for (;;) {
            more = advance();
            if (more) prepare(Gn);
            __builtin_amdgcn_sched_barrier(0);
            if (!more) U_WAIT(0); else if (it == 0) U_WAIT(12); else U_WAIT(13);
            const u32x4 SCr = *(const LAS u32x4*)(wl + scrd);
            asm volatile("s_waitcnt lgkmcnt(0)" ::: "memory");
            f32x4 acc = (f32x4){0.f, 0.f, 0.f, 0.f};
            U_Q(0) if (more) { U_SCDMA(); U_DMA(0) if (it == 0) U_WAIT(13); else U_WAIT(14); }
            U_Q(1) if (more) { U_DMA(1) if (it == 0) U_WAIT(13); else U_WAIT(14); }
            U_Q(2) if (more) { U_DMA(2) if (it == 0) U_WAIT(13); else U_WAIT(14); }
            U_Q(3) if (more) { U_DMA(3) }
            asm volatile("s_nop 15\n\ts_nop 15" : "+v"(acc));
            const int tsl = n16 >> 1;
            float v0 = ((Gc.t0 >> 7) == tsl) ? acc[0] : 0.f, v1 = ((Gc.t1 >> 7) == tsl) ? acc[1] : 0.f, v2 = ((Gc.t2 >> 7) == tsl) ? acc[2] : 0.f, v3 = ((Gc.t3 >> 7) == tsl) ? acc[3] : 0.f;
            v0 += dpp_f<0xB1>(v0); v1 += dpp_f<0xB1>(v1); v2 += dpp_f<0xB1>(v2); v3 += dpp_f<0xB1>(v3);
            v0 += dpp_f<0x4E>(v0); v1 += dpp_f<0x4E>(v1); v2 += dpp_f<0x4E>(v2); v3 += dpp_f<0x4E>(v3);
            v0 += dpp_f<0x141>(v0); v1 += dpp_f<0x141>(v1); v2 += dpp_f<0x141>(v2); v3 += dpp_f<0x141>(v3);
            v0 += dpp_f<0x140>(v0); v1 += dpp_f<0x140>(v1); v2 += dpp_f<0x140>(v2); v3 += dpp_f<0x140>(v3);
            const float s01 = (n16 & 1) ? v1 : v0, s23 = (n16 & 1) ? v3 : v2, s = (n16 & 2) ? s23 : s01;
            const bool mine = (n16 >> 2) == (it & 3);
            sacc = mine ? s : sacc; pkacc = mine ? Gc.pkr : pkacc;
            float* dst = dump + lane; float val = 0.f;
            if ((it & 3) == 3 || !more) { val = gelu_erf(sacc); dst = pkacc >= 0 ? ACT + (size_t)tok0 * 128 + pkacc : dst; pkacc = -1; }
            *dst = val;
            if (!more) break;
            Gc = Gn; ++it;
        }
#undef U_MMA
#undef U_Q
#undef U_DMA
#undef U_SCDMA
#undef U_WAIT
        asm volatile("s_waitcnt vmcnt(0) lgkmcnt(0)" ::: "memory");
    }
}

struct RowBufV { u32x4 v; unsigned char s; };
__device__ __forceinline__ void p8v_load(RowBufV& b, const __amdgpu_buffer_rsrc_t rv, int e, int lane) {
    b.v = __builtin_amdgcn_raw_buffer_load_b128(rv, lane * 16, e * 1024, P8_AUX); b.s = __builtin_amdgcn_raw_buffer_load_b8(rv, lane, (int)EXP_SC_OFF + e * 64, 0);
}
#define PV_FMA(acc, p) asm("v_pk_fma_f32 %0, %1, %2, %0 op_sel_hi:[0,1,1]" : "+v"(acc) : "s"(cc), "v"(p))
__device__ __forceinline__ void p8v_axpy(const RowBufV& b, float c, f32x2 (&y)[8][2]) {
    const float sc = __uint_as_float((b.s & 0xffu) << 23);
    const unsigned long long cc = (unsigned long long)__float_as_uint(c);
#pragma unroll
    for (int d = 0; d < 4; ++d) {
        const f32x2 p0 = __builtin_amdgcn_cvt_scalef32_pk_f32_fp4(b.v[d], sc, 0), p1 = __builtin_amdgcn_cvt_scalef32_pk_f32_fp4(b.v[d], sc, 1);
        const f32x2 p2 = __builtin_amdgcn_cvt_scalef32_pk_f32_fp4(b.v[d], sc, 2), p3 = __builtin_amdgcn_cvt_scalef32_pk_f32_fp4(b.v[d], sc, 3);
        PV_FMA(y[2 * d][0], p0); PV_FMA(y[2 * d][1], p1); PV_FMA(y[2 * d + 1][0], p2); PV_FMA(y[2 * d + 1][1], p3);
    }
}
#undef PV_FMA
constexpr int VG = 8;
__device__ __forceinline__ void p8v_load_group(RowBufV (&R)[VG], const __amdgpu_buffer_rsrc_t rv, int e_lo, int e_hi, int g, int lane) {
    const int ev = g < 64 / VG ? e_lo : e_hi, kb = (VG * g) & 63;
#pragma unroll
    for (int i = 0; i < VG; ++i) p8v_load(R[i], rv, __builtin_amdgcn_readlane(ev, kb + i), lane);
}
__device__ __forceinline__ void p8v_group(const RowBufV (&R)[VG], int g, int c_lo, int c_hi, f32x2 (&y)[8][2]) {
    const int cv = g < 64 / VG ? c_lo : c_hi, kb = (VG * g) & 63;
#pragma unroll
    for (int i = 0; i < VG; ++i) p8v_axpy(R[i], __int_as_float(__builtin_amdgcn_readlane(cv, kb + i)), y);
}
__device__ __forceinline__ void pv_epilogue(const Args& a, int token, f32x2 (&y)[8][2], int lane) {
    const bf16_t* R1 = (const bf16_t*)(a.ws + WS_A2);
    u32x2 r1w[8];
    { const u32x2* hp = (const u32x2*)(R1 + (size_t)token * D) + lane;
#pragma unroll
      for (int m = 0; m < 8; ++m) r1w[m] = hp[64 * m]; }
    const long long* st1 = (const long long*)(a.ws + WS_STATS) + 2 * (size_t)token;
    const float sm1 = (float)st1[0] * (1.0f / STAT_FX), sq1 = (float)st1[1] * (1.0f / STAT_FX);
    const float mean1 = sm1 * (1.0f / D), rstd1 = rsqrtf(fmaxf(sq1 * (1.0f / D) - mean1 * mean1, 0.f) + LN_EPS);
    const f32x4* g14 = (const f32x4*)a.in[12] + lane; const f32x4* b14 = (const f32x4*)a.in[13] + lane;
    const f32x4* g4 = (const f32x4*)a.in[19] + lane; const f32x4* b4 = (const f32x4*)a.in[20] + lane;
    f32x4 gg2[8], bb2[8];
#pragma unroll
    for (int m = 0; m < 8; ++m) { gg2[m] = g4[64 * m]; bb2[m] = b4[64 * m]; }
    float s = 0.f;
#pragma unroll
    for (int m = 0; m < 8; ++m) { const u32x2 w = r1w[m]; const f32x4 gg = g14[64 * m], bb = b14[64 * m];
        const f32x2 ha = (f32x2){(bflo(w.x) - mean1) * rstd1 * gg[0] + bb[0], (bfhi(w.x) - mean1) * rstd1 * gg[1] + bb[1]}, hc = (f32x2){(bflo(w.y) - mean1) * rstd1 * gg[2] + bb[2], (bfhi(w.y) - mean1) * rstd1 * gg[3] + bb[3]};
        y[m][0] = y[m][0] + ALPHA * ha; y[m][1] = y[m][1] + ALPHA * hc;
        s += (y[m][0].x + y[m][0].y) + (y[m][1].x + y[m][1].y); }
    const float mean = wave_sum(s) * (1.f / D); float s2 = 0.f;
#pragma unroll
    for (int m = 0; m < 8; ++m)
#pragma unroll
        for (int h = 0; h < 2; ++h) { y[m][h] = y[m][h] - mean; s2 += y[m][h].x * y[m][h].x + y[m][h].y * y[m][h].y; }
    const float rstd = rsqrtf(wave_sum(s2) * (1.f / D) + LN_EPS);
    f32x4* o4 = (f32x4*)(a.out + (size_t)token * D) + lane;
#pragma unroll
    for (int m = 0; m < 8; ++m) { const f32x4 gg = gg2[m], bb = bb2[m];
        f32x4 o; o[0] = y[m][0].x * rstd * gg[0] + bb[0]; o[1] = y[m][0].y * rstd * gg[1] + bb[1]; o[2] = y[m][1].x * rstd * gg[2] + bb[2]; o[3] = y[m][1].y * rstd * gg[3] + bb[3];
        __builtin_nontemporal_store(o, o4 + 64 * m); }
}
struct PvPar { u32x2 g1[8], b1[8], g2[8], b2[8]; };
struct PvRow { u32x2 r1w[8]; long long s0, s1; };
__device__ __forceinline__ void pv_par_load(const Args& a, int lane, PvPar& P) {
    const u32x2* pp = (const u32x2*)(a.ws + WS_LNP) + lane;
#pragma unroll
    for (int m = 0; m < 8; ++m) { P.g1[m] = pp[64 * m]; P.b1[m] = pp[512 + 64 * m]; P.g2[m] = pp[1024 + 64 * m]; P.b2[m] = pp[1536 + 64 * m]; }
}
__device__ __forceinline__ void pv_row_load(const Args& a, int token, int lane, PvRow& R) {
    const u32x2* hp = (const u32x2*)((const bf16_t*)(a.ws + WS_A2) + (size_t)token * D) + lane;
#pragma unroll
    for (int m = 0; m < 8; ++m) R.r1w[m] = hp[64 * m];
    const long long* st1 = (const long long*)(a.ws + WS_STATS) + 2 * (size_t)token; R.s0 = st1[0]; R.s1 = st1[1];
}
__device__ __forceinline__ void pv_epilogue_sw(const Args& a, int token, f32x2 (&y)[8][2], int lane, PvPar& P, const PvRow& R) {
#pragma unroll
    for (int m = 0; m < 8; ++m) asm volatile("" : "+v"(P.g1[m].x), "+v"(P.g1[m].y), "+v"(P.b1[m].x), "+v"(P.b1[m].y), "+v"(P.g2[m].x), "+v"(P.g2[m].y), "+v"(P.b2[m].x), "+v"(P.b2[m].y));
    const float sm1 = (float)R.s0 * (1.0f / STAT_FX), sq1 = (float)R.s1 * (1.0f / STAT_FX);
    const float mean1 = sm1 * (1.0f / D), rstd1 = rsqrtf(fmaxf(sq1 * (1.0f / D) - mean1 * mean1, 0.f) + LN_EPS);
    float s = 0.f;
#pragma unroll
    for (int m = 0; m < 8; ++m) { const u32x2 w = R.r1w[m], g = P.g1[m], b = P.b1[m];
        const f32x2 ha = (f32x2){(bflo(w.x) - mean1) * rstd1 * bflo(g.x) + bflo(b.x), (bfhi(w.x) - mean1) * rstd1 * bfhi(g.x) + bfhi(b.x)}, hc = (f32x2){(bflo(w.y) - mean1) * rstd1 * bflo(g.y) + bflo(b.y), (bfhi(w.y) - mean1) * rstd1 * bfhi(g.y) + bfhi(b.y)};
        y[m][0] = y[m][0] + ALPHA * ha; y[m][1] = y[m][1] + ALPHA * hc;
        s += (y[m][0].x + y[m][0].y) + (y[m][1].x + y[m][1].y); }
    const float mean = wave_sum(s) * (1.f / D); float s2 = 0.f;
#pragma unroll
    for (int m = 0; m < 8; ++m)
#pragma unroll
        for (int h = 0; h < 2; ++h) { y[m][h] = y[m][h] - mean; s2 += y[m][h].x * y[m][h].x + y[m][h].y * y[m][h].y; }
    const float rstd = rsqrtf(wave_sum(s2) * (1.f / D) + LN_EPS);
    f32x4* o4 = (f32x4*)(a.out + (size_t)token * D) + lane;
#pragma unroll
    for (int m = 0; m < 8; ++m) { const u32x2 g = P.g2[m], b = P.b2[m];
        f32x4 o; o[0] = y[m][0].x * rstd * bflo(g.x) + bflo(b.x); o[1] = y[m][0].y * rstd * bfhi(g.x) + bfhi(b.x); o[2] = y[m][1].x * rstd * bflo(g.y) + bflo(b.y); o[3] = y[m][1].y * rstd * bfhi(g.y) + bfhi(b.y);
        __builtin_nontemporal_store(o, o4 + 64 * m); }
}
typedef _Float16 h2_t __attribute__((ext_vector_type(2)));
typedef unsigned u32x16v __attribute__((ext_vector_type(16)));
constexpr int HG = 8;
__device__ __forceinline__ void phase_v(const Args& a, LAS unsigned char* lds) {
    int lane = threadIdx.x & 63; const int wave = __builtin_amdgcn_readfirstlane((int)(threadIdx.x >> 6)), gw = blockIdx.x * NWAVE + wave, NGW = gridDim.x * NWAVE;
    LAS unsigned char* wl = lds + wave * U_WAVE_LDS;
    LAS unsigned short* elist = (LAS unsigned short*)(wl);
    LAS int* offT = (LAS int*)(wl + 1024);
    LAS unsigned short* cst = (LAS unsigned short*)(wl + 1024 + 320);
    LAS float* cw = (LAS float*)(wl + 2048);
    const __amdgpu_buffer_rsrc_t rv = __builtin_amdgcn_make_buffer_rsrc((void*)(a.ws + WS_EV), 0, 17 * 1024 * 1024, 0x00020000);
    const int* IDX = (const int*)(a.ws + WS_POOLED); const float* GATE = (const float*)(a.ws + WS_POOLED + 8 * MiB); const float* ACT = (const float*)(a.ws + WS_POOLED + 16 * MiB);
#pragma unroll 1
    for (int st = 2 * gw; st < M / 4; st = (st & 1) ? st + 2 * NGW - 1 : st + 1) {
        asm volatile("" : "+v"(lane));
        const int tok0 = __builtin_amdgcn_readfirstlane(st * 4);
        { int el[4], eh[4];
#pragma unroll
          for (int t = 0; t < 4; ++t) { const size_t o = (size_t)(tok0 + t) * 128; el[t] = IDX[o + lane]; eh[t] = IDX[o + 64 + lane]; }
#pragma unroll
          for (int k = 0; k < 8; ++k) { const size_t o = (size_t)tok0 * 128 + 64 * k + lane; cw[64 * k + lane] = GATE[o] * ACT[o]; }
#pragma unroll
          for (int t = 0; t < 4; ++t) {
              elist[t * 128 + lane] = (unsigned short)el[t]; elist[t * 128 + 64 + lane] = (unsigned short)eh[t];
              const int b_lo = el[t] >> 10, b_hi = eh[t] >> 10; int base = 0;
#pragma unroll 1
              for (int b = 0; b < 16; ++b) { if (lane == 0) offT[t * 18 + b] = base; base += __popcll(__ballot(b_lo == b)) + __popcll(__ballot(b_hi == b)); }
              if (lane == 0) offT[t * 18 + 16] = 128; } }
        asm volatile("s_waitcnt lgkmcnt(0)" ::: "memory");
        { const int t0 = lane & 3, bb = lane >> 2;
          const int n0 = offT[t0 * 18 + bb + 1] - offT[t0 * 18 + bb];
          int inc = n0;
#pragma unroll
          for (int o = 1; o < 64; o <<= 1) { const int up = __shfl_up(inc, o); inc += (lane >= o) ? up : 0; }
          cst[lane] = (unsigned short)(inc - n0);
          if (lane == 63) cst[64] = (unsigned short)512; }
        asm volatile("s_waitcnt lgkmcnt(0)" ::: "memory");
        auto round_vec = [&](int R, int& ev, int& pkv, int& cv) __attribute__((always_inline)) {
            const int q = 64 * R + lane; int c = 0, base = 0;
#pragma unroll
            for (int step = 32; step >= 1; step >>= 1) { const int v = (int)cst[c + step]; const bool ge = v <= q; c = ge ? c + step : c; base = ge ? v : base; }
            const int t = c & 3, pos = offT[t * 18 + (c >> 2)] + (q - base);
            ev = (int)elist[t * 128 + pos]; pkv = t * 128 + pos;
            cv = (int)(__builtin_bit_cast(unsigned, __builtin_amdgcn_cvt_pkrtz(0.f, cw[pkv])) | (unsigned)(t << 4));
        };
        u32x16v Y0 = (u32x16v)(0u), Y1 = (u32x16v)(0u), Y2 = (u32x16v)(0u), Y3 = (u32x16v)(0u);
        int e_cur, pk_cur, c_cur, e_nxt, pk_nxt, c_nxt;
        round_vec(0, e_cur, pk_cur, c_cur); round_vec(1, e_nxt, pk_nxt, c_nxt);
        RowBufV B0[HG], B1[HG], B2[HG];
        constexpr int NGR = 512 / HG;
#define PVH_LD(buf, Gl, Gc) do { { const int ev_ = (((Gl) >> 3) == ((Gc) >> 3)) ? e_cur : e_nxt; const int li_ = (HG * (Gl)) & 63; \
            _Pragma("unroll") for (int i = 0; i < HG; ++i) p8v_load(buf[i], rv, __builtin_amdgcn_readlane(ev_, li_ + i), lane); } __builtin_amdgcn_sched_barrier(0); } while (0)
#define PVH_ROW(buf, i, li) { const int s_ = __builtin_amdgcn_readlane(c_cur, (li) + (i));     \
            const float sc_ = __uint_as_float((buf[i].s & 0xffu) << 23); h2_t p_[16]; \
            _Pragma("unroll") for (int d = 0; d < 4; ++d) { p_[4 * d] = __builtin_amdgcn_cvt_scalef32_pk_f16_fp4(buf[i].v[d], sc_, 0); p_[4 * d + 1] = __builtin_amdgcn_cvt_scalef32_pk_f16_fp4(buf[i].v[d], sc_, 1); \
                p_[4 * d + 2] = __builtin_amdgcn_cvt_scalef32_pk_f16_fp4(buf[i].v[d], sc_, 2); p_[4 * d + 3] = __builtin_amdgcn_cvt_scalef32_pk_f16_fp4(buf[i].v[d], sc_, 3); } \
            asm volatile("s_set_gpr_idx_on %[o], 0xc\n\t" "v_pk_fma_f16 v176, %[o], %[p0], v176 op_sel:[1,0,0] op_sel_hi:[1,1,1]\n\t" "v_pk_fma_f16 v177, %[o], %[p1], v177 op_sel:[1,0,0] op_sel_hi:[1,1,1]\n\t" "v_pk_fma_f16 v178, %[o], %[p2], v178 op_sel:[1,0,0] op_sel_hi:[1,1,1]\n\t" "v_pk_fma_f16 v179, %[o], %[p3], v179 op_sel:[1,0,0] op_sel_hi:[1,1,1]\n\t" "v_pk_fma_f16 v180, %[o], %[p4], v180 op_sel:[1,0,0] op_sel_hi:[1,1,1]\n\t" "v_pk_fma_f16 v181, %[o], %[p5], v181 op_sel:[1,0,0] op_sel_hi:[1,1,1]\n\t" "v_pk_fma_f16 v182, %[o], %[p6], v182 op_sel:[1,0,0] op_sel_hi:[1,1,1]\n\t" "v_pk_fma_f16 v183, %[o], %[p7], v183 op_sel:[1,0,0] op_sel_hi:[1,1,1]\n\t" "v_pk_fma_f16 v184, %[o], %[p8], v184 op_sel:[1,0,0] op_sel_hi:[1,1,1]\n\t" "v_pk_fma_f16 v185, %[o], %[p9], v185 op_sel:[1,0,0] op_sel_hi:[1,1,1]\n\t" "v_pk_fma_f16 v186, %[o], %[p10], v186 op_sel:[1,0,0] op_sel_hi:[1,1,1]\n\t" "v_pk_fma_f16 v187, %[o], %[p11], v187 op_sel:[1,0,0] op_sel_hi:[1,1,1]\n\t" "v_pk_fma_f16 v188, %[o], %[p12], v188 op_sel:[1,0,0] op_sel_hi:[1,1,1]\n\t" "v_pk_fma_f16 v189, %[o], %[p13], v189 op_sel:[1,0,0] op_sel_hi:[1,1,1]\n\t" "v_pk_fma_f16 v190, %[o], %[p14], v190 op_sel:[1,0,0] op_sel_hi:[1,1,1]\n\t" "v_pk_fma_f16 v191, %[o], %[p15], v191 op_sel:[1,0,0] op_sel_hi:[1,1,1]\n\t" "s_set_gpr_idx_off" \
                : "+{v[176:191]}"(Y0), "+{v[192:207]}"(Y1), "+{v[208:223]}"(Y2), "+{v[224:239]}"(Y3) : [o]"s"(s_), [p0]"v"(p_[0]), [p1]"v"(p_[1]), [p2]"v"(p_[2]), [p3]"v"(p_[3]), [p4]"v"(p_[4]), [p5]"v"(p_[5]), [p6]"v"(p_[6]), [p7]"v"(p_[7]), [p8]"v"(p_[8]), [p9]"v"(p_[9]), [p10]"v"(p_[10]), [p11]"v"(p_[11]), [p12]"v"(p_[12]), [p13]"v"(p_[13]), [p14]"v"(p_[14]), [p15]"v"(p_[15]) : "m0"); \
            __builtin_amdgcn_sched_barrier(0); }
#define PVH_CP(buf, Gc) do { const int li_ = (HG * (Gc)) & 63; PVH_ROW(buf, 0, li_) PVH_ROW(buf, 1, li_) PVH_ROW(buf, 2, li_) PVH_ROW(buf, 3, li_) PVH_ROW(buf, 4, li_) PVH_ROW(buf, 5, li_) PVH_ROW(buf, 6, li_) PVH_ROW(buf, 7, li_) __builtin_amdgcn_sched_barrier(0); } while (0)
        PVH_LD(B0, 0, 0); PVH_LD(B1, 1, 0);
#define PVH_STEP(bl, bc, Gc) do { \
            if ((((Gc) & 7) == 0) && (Gc) != 0) { e_cur = e_nxt; pk_cur = pk_nxt; c_cur = c_nxt; const int Rn = ((Gc) >> 3) + 1; if (Rn < NGR / 8) round_vec(Rn, e_nxt, pk_nxt, c_nxt); } \
            PVH_LD(bl, (Gc) + 2, (Gc)); PVH_CP(bc, (Gc)); } while (0)
#pragma unroll 1
        for (int G = 0; G < NGR - 1; G += 3) {
            PVH_STEP(B2, B0, G);
            PVH_STEP(B0, B1, G + 1);
            PVH_STEP(B1, B2, G + 2);
        }
        PvPar P; PvRow RA, RB;
        pv_row_load(a, tok0, lane, RA); pv_par_load(a, lane, P); __builtin_amdgcn_sched_barrier(0);
        PVH_STEP(B2, B0, NGR - 1);
#undef PVH_STEP
#undef PVH_LD
#undef PVH_ROW
#undef PVH_CP
        asm volatile("" : "+v"(lane));
#define PVH_FIN(Yt, t, Rc, Rn) { if ((t) < 3) pv_row_load(a, tok0 + (t) + 1, lane, Rn); f32x2 y[8][2]; \
            _Pragma("unroll") for (int m = 0; m < 8; ++m) { const unsigned w0 = Yt[2 * m], w1 = Yt[2 * m + 1];       \
                const h2_t h0 = __builtin_bit_cast(h2_t, w0), h1 = __builtin_bit_cast(h2_t, w1); y[m][0] = (f32x2){(float)h0.x, (float)h0.y}; y[m][1] = (f32x2){(float)h1.x, (float)h1.y}; } \
            pv_epilogue_sw(a, tok0 + (t), y, lane, P, Rc); }
        PVH_FIN(Y0, 0, RA, RB) PVH_FIN(Y1, 1, RB, RA) PVH_FIN(Y2, 2, RA, RB) PVH_FIN(Y3, 3, RB, RA)
#undef PVH_FIN
        asm volatile("s_waitcnt vmcnt(0) lgkmcnt(0)" ::: "memory");
    }
}

#define XB_TMO      128
#define XB_XCNT(j)  (256  + 64 * (j))
#define XB_XSUB(j)  (1280 + 64 * (j))
#define XB_XGEN(j)  (2304 + 64 * (j))
#define XB_TOP      3328
#define XB_TOPGEN   3392
#define XCD_BAR_WORDS 3456
#define XB_SPIN_CAP (1u << 18)
__device__ __forceinline__ unsigned xb_ld(unsigned* p)              { return __hip_atomic_load(p, __ATOMIC_RELAXED, __HIP_MEMORY_SCOPE_AGENT); }
__device__ __forceinline__ unsigned xb_add(unsigned* p, unsigned v) { return __hip_atomic_fetch_add(p, v, __ATOMIC_RELAXED, __HIP_MEMORY_SCOPE_AGENT); }
__device__ __forceinline__ unsigned xb_xcc_id() { return (unsigned)__builtin_amdgcn_s_getreg((3 << 11) | 20) & 0xFu; }
#define XB_SPIN(cond, bar) do { unsigned _sp = 0; while (cond) { __builtin_amdgcn_s_sleep(1); \
    if ((++_sp & 255u) == 0u) { if (xb_ld(&(bar)[XB_TMO])) break; if (_sp > XB_SPIN_CAP) { atomicAdd(&(bar)[XB_TMO], 1u); break; } } } } while (0)
struct XcdBarrier { unsigned* bar; unsigned x; volatile LAS unsigned* st; };
__device__ __forceinline__ XcdBarrier xcd_barrier_post(unsigned* bar, volatile LAS unsigned* st) {
    XcdBarrier b; b.bar = bar; b.x = xb_xcc_id(); b.st = st;
    if (threadIdx.x == 0) (void)xb_add(&bar[XB_XCNT(b.x)], 1u);
    return b;
}
__device__ __forceinline__ void xcd_barrier_complete(unsigned* bar, unsigned x, unsigned& nloc, unsigned& nx) {
    const unsigned G = gridDim.x * gridDim.y * gridDim.z;
    unsigned sum, cnt, mine, sp = 0u;
    for (;;) {
        sum = 0u; cnt = 0u; mine = 0u;
#pragma unroll
        for (unsigned j = 0; j < 16; ++j) { const unsigned c = xb_ld(&bar[XB_XCNT(j)]); sum += c; cnt += (c > 0u) ? 1u : 0u; mine = (j == x) ? c : mine; }
        if (sum == G) break;
        __builtin_amdgcn_s_sleep(1);
        if ((++sp & 255u) == 0u) { if (xb_ld(&bar[XB_TMO])) break; if (sp > XB_SPIN_CAP) { atomicAdd(&bar[XB_TMO], 1u); break; } }
    }
    nloc = mine > 0u ? mine : 1u; nx = cnt > 0u ? cnt : 1u;
}
__device__ __forceinline__ void xcd_barrier(const XcdBarrier& b) {
    asm volatile("s_waitcnt vmcnt(0)" ::: "memory");
    __syncthreads();
    if (threadIdx.x == 0) {
        unsigned* bar = b.bar;
        __builtin_amdgcn_s_waitcnt(0);
        unsigned nloc = b.st[0], nx = b.st[1];
        if (nloc == 0u) { xcd_barrier_complete(bar, b.x, nloc, nx); b.st[0] = nloc; b.st[1] = nx; }
        const unsigned old = xb_add(&bar[XB_XSUB(b.x)], 1u);
        const unsigned gen = old / nloc;
        if (old + 1u == (gen + 1u) * nloc) {
            __builtin_amdgcn_fence(__ATOMIC_RELEASE, "agent");
            asm volatile("s_waitcnt vmcnt(0)" ::: "memory");
            const unsigned og = xb_add(&bar[XB_TOP], 1u);
            const unsigned tg = og / nx;
            if (og + 1u == (tg + 1u) * nx) xb_add(&bar[XB_TOPGEN], 1u);
            else XB_SPIN(xb_ld(&bar[XB_TOPGEN]) == tg, bar);
            __builtin_amdgcn_fence(__ATOMIC_ACQUIRE, "agent");
            xb_add(&bar[XB_XGEN(b.x)], 1u);
            asm volatile("s_waitcnt vmcnt(0)" ::: "memory");
        } else {
            XB_SPIN(xb_ld(&bar[XB_XGEN(b.x)]) == gen, bar);
            __builtin_amdgcn_fence(__ATOMIC_ACQUIRE, "agent");
            asm volatile("s_waitcnt vmcnt(0)" ::: "memory");
        }
    }
    __syncthreads();
}

__global__ void __launch_bounds__(NTH, 2) mk_fwd(Args a) {
    extern __shared__ __attribute__((aligned(16))) unsigned char lds_raw[];
    LAS unsigned char* lds = (LAS unsigned char*)lds_raw;
    unsigned char* ws = a.ws;
    bf16_t* PG = (bf16_t*)a.out;
    const int lo = a.ph_lo, hi = a.ph_hi;
#ifndef PHASE_MASK
#define PHASE_MASK 0x7ff
#endif
#define IN(k) (((PHASE_MASK >> (k)) & 1) && lo <= (k) && (k) < hi)
#define SYNC(k) do { if (IN(k) && IN((k) + 1)) xcd_barrier(xb); } while (0)
    volatile LAS unsigned* xst = (volatile LAS unsigned*)(lds + LDS_BYTES - 1024);
    if (threadIdx.x < 2) xst[threadIdx.x] = 0u;
    __syncthreads();
    XcdBarrier xb; xb.bar = (unsigned*)(ws + WS_CTL); xb.x = 0; xb.st = xst;
    if (hi - lo > 1) xb = xcd_barrier_post((unsigned*)(ws + WS_CTL), xst);
    if (IN(0)) { phase0(a, lds); xcd_barrier(xb); phase0b(a); } SYNC(0);
    if (IN(1)) {
        { GemmDesc g{(const bf16_t*)(ws + WS_H0_8), D / 2, (const bf16_t*)(ws + WS_WIN8), D / 2, M, 8192, D / 2, 0};
          EpiGen E{(bf16_t*)(ws + WS_PAZ), 4096, PG, 4096, (const float*)(ws + WS_CAMAX), nullptr, 0, nullptr, 0, 0.f, nullptr, nullptr, 0, nullptr, nullptr, nullptr, nullptr, (const float*)(ws + WS_SA)};
          pg8::gemm_phase<2>(lds, g, E); }
        meta_proj(a);
    } SYNC(1);
    if (IN(2)) { phase2(a); }
    do { if (IN(2) && IN(4)) xcd_barrier(xb); } while (0);
    if (IN(4)) { ln1_fold_vectors(a); }
    if (IN(4)) {
        GemmDesc g{(const bf16_t*)(ws + WS_A2), 2048, (const bf16_t*)(ws + WS_W2_T), 2048, M, 2048, 2048, 0};
        EpiGen E{(bf16_t*)(ws + WS_PAZ), 2048, nullptr, NO_SPLIT, nullptr, nullptr, 0, nullptr, 0, 0.f, (const unsigned char*)PG, (const unsigned char*)PG + 2048, 4096, nullptr, nullptr, nullptr, nullptr};
        run_gemm(lds, g, E);
    } SYNC(4);
    if (IN(5)) {
        GemmDesc g{(const bf16_t*)(ws + WS_PAZ), 2048, (const bf16_t*)(ws + WS_WO_T), 2048, M, 2048, 2048, 0};
        EpiGen E{(bf16_t*)(ws + WS_A2), 2048, nullptr, NO_SPLIT, nullptr, nullptr, 0, (const bf16_t*)(ws + WS_H0), 2048, ALPHA, nullptr, nullptr, 0, (unsigned long long*)(ws + WS_STATS), nullptr, nullptr, nullptr};
        run_gemm(lds, g, E);
    }
    do { if (IN(5) && IN(7)) xcd_barrier(xb); } while (0);
    if (IN(7)) {
        GemmDesc g{(const bf16_t*)(ws + WS_A2), 2048, (const bf16_t*)(ws + WS_WQ_T), 2048, M, 2048, 2048, 0};
        EpiGen E{(bf16_t*)(ws + WS_PAZ + 64 * MiB), 2048, nullptr, NO_SPLIT, nullptr, nullptr, 0, nullptr, 0, 0.f, nullptr, nullptr, 0, nullptr, (const long long*)(ws + WS_STATS), (const float*)(ws + WS_CS), (const float*)(ws + WS_BW)};
        run_gemm(lds, g, E);
    } SYNC(7);
    if (IN(8)) { phase7(a, lds); } SYNC(8);
    if (IN(9)) { phase_u(a, lds); } SYNC(9);
    if (IN(10)) { phase_v(a, lds); }
#undef IN
#undef SYNC
}
constexpr int N_PHASES = 11;

extern "C" void kernel_launch(void* const* d_in, const int* in_sizes, int n_in, void* d_out, int out_size, void* d_ws, size_t ws_size, hipStream_t stream) {
    static int grid = 0;
    if (grid == 0) {
        if (n_in != 21 || out_size != M * D || ws_size < WS_END) { fprintf(stderr, "kernel_launch: unexpected problem shape (n_in %d out %d ws %zu)\n", n_in, out_size, ws_size); grid = -1; return; }
        int dev = 0, cus = 0, per_cu = 0;
        hipGetDevice(&dev); hipDeviceGetAttribute(&cus, hipDeviceAttributeMultiprocessorCount, dev);
        hipFuncSetAttribute((const void*)mk_fwd, hipFuncAttributeMaxDynamicSharedMemorySize, LDS_BYTES);
        hipOccupancyMaxActiveBlocksPerMultiprocessor(&per_cu, (const void*)mk_fwd, NTH, LDS_BYTES);
        if (per_cu < 1) { fprintf(stderr, "kernel_launch: occupancy query says %d blocks per CU: the grid barrier needs every workgroup resident; nothing launched\n", per_cu); grid = -1; return; }
        grid = cus * 1;
        (void)hipGetLastError();
    }
    if (grid < 0) return;
    Args a{};
    for (int i = 0; i < 21; ++i) a.in[i] = (const float*)d_in[i];
    a.out = (float*)d_out; a.ws = (unsigned char*)d_ws;
#if N_LAUNCH_MODE == 0
    for (int p = 0; p < N_PHASES; ++p) { a.ph_lo = p; a.ph_hi = p + 1; hipLaunchKernelGGL(mk_fwd, dim3(grid), dim3(NTH), LDS_BYTES, stream, a); }
#else
    a.ph_lo = 0; a.ph_hi = N_PHASES;
    if (hipMemsetAsync((char*)d_ws + WS_CAMAX, 0, 8192 * 4, stream) != hipSuccess) { fprintf(stderr, "kernel_launch: memset of the column maxima failed\n"); return; }
    if (hipMemsetAsync((char*)d_ws + WS_CTL, 0, XCD_BAR_WORDS * 4, stream) != hipSuccess) { fprintf(stderr, "kernel_launch: memset of barrier words failed\n"); return; }
    void* args[] = {&a};
    hipError_t e = hipLaunchCooperativeKernel((const void*)mk_fwd, dim3(grid), dim3(NTH), args, LDS_BYTES, stream);
    if (e != hipSuccess) fprintf(stderr, "cooperative launch failed: %s (grid %d)\n", hipGetErrorString(e), grid);
#endif
}
```
